# Optimizing an MI355X kernel written in HIP

```python
import math
import jax
import jax.numpy as jnp
from jax import lax
import numpy as np


D_MODEL = 1024
BATCH = 4
SEQ = 4096
DEPTH = 4

CHUNK = 64
Q_BLOCK = 128
N_A_LAYERS = DEPTH // 2
N_B_LAYERS = DEPTH - N_A_LAYERS
DIFF_HEAD_DIM = 64
DIFF_V_DIM = 2 * DIFF_HEAD_DIM
DIFF_HEADS = D_MODEL // DIFF_V_DIM
DIFF_WIDTH = DIFF_HEADS * DIFF_V_DIM
MLA_NOPE_DIM = 128
MLA_ROPE_DIM = 64
MLA_V_DIM = 128
MLA_HEADS = D_MODEL // MLA_V_DIM
MLA_Q_RANK = 384
MLA_KV_RANK = 256
ROPE_BASE = 10000.0
N_EXPERTS = 32
N_GROUPS = 8
TOP_K = 2
EXPERT_FF = 256
NORM_EPS = 1e-5
DEEPNORM_ALPHA = (2 * DEPTH) ** 0.25
DEEPNORM_BETA = (8 * DEPTH) ** -0.25

kernel_name = 'hybrid_diffattn_mla_moe_deepnorm'


def _layernorm(x, g, b):
    xf = x.astype(jnp.float32)
    mu = jnp.mean(xf, axis=-1, keepdims=True)
    var = jnp.mean(jnp.square(xf - mu), axis=-1, keepdims=True)
    return ((xf - mu) * lax.rsqrt(var + NORM_EPS) * g.astype(jnp.float32) + b.astype(jnp.float32)).astype(x.dtype)


def _rmsnorm(x, g):
    xf = x.astype(jnp.float32)
    inv = lax.rsqrt(jnp.mean(jnp.square(xf), axis=-1, keepdims=True) + NORM_EPS)
    return (xf * inv * g.astype(jnp.float32)).astype(x.dtype)


def _rope_tables(seq):
    inv_freq = ROPE_BASE ** (-jnp.arange(0, MLA_ROPE_DIM, 2, dtype=jnp.float32) / MLA_ROPE_DIM)
    ang = jnp.arange(seq, dtype=jnp.float32)[:, None] * inv_freq[None, :]
    return jnp.cos(ang), jnp.sin(ang)


def _rope(x, cos, sin):
    xf = x.astype(jnp.float32)
    x1, x2 = jnp.split(xf, 2, axis=-1)
    return jnp.concatenate([x1 * cos - x2 * sin, x2 * cos + x1 * sin], axis=-1).astype(x.dtype)


def _alibi_slopes(n_heads):
    return 2.0 ** (-8.0 * jnp.arange(1, n_heads + 1, dtype=jnp.float32) / n_heads)


def _chunk_causal_mask(q0, q1):
    q_chunk = jnp.arange(q0, q1) // CHUNK
    k_chunk = jnp.arange(q1) // CHUNK
    return k_chunk[None, :] <= q_chunk[:, None]


def _sweep_query_blocks(seq, block_fn):
    return jnp.concatenate([block_fn(q0, q0 + Q_BLOCK) for q0 in range(0, seq, Q_BLOCK)], axis=1)


def _lambda_init(layer):
    return 0.8 - 0.6 * math.exp(-0.3 * layer)


def _diff_attention(x, w_qkv, lam, subln_g, w_o, lambda_init):
    b, s, _ = x.shape
    q, k, v = jnp.split(x @ w_qkv, 3, axis=-1)
    q = q.reshape(b, s, DIFF_HEADS, 2, DIFF_HEAD_DIM) * (DIFF_HEAD_DIM ** -0.5)
    k = k.reshape(b, s, DIFF_HEADS, 2, DIFF_HEAD_DIM)
    v = v.reshape(b, s, DIFF_HEADS, DIFF_V_DIM)
    lf = lam.astype(jnp.float32)
    lam_full = jnp.exp(jnp.sum(lf[0] * lf[1])) - jnp.exp(jnp.sum(lf[2] * lf[3])) + lambda_init
    slopes = _alibi_slopes(DIFF_HEADS)[:, None, None, None]

    def block(q0, q1):
        logits = jnp.einsum('bqhcd,bkhcd->bhcqk', q[:, q0:q1], k[:, :q1]).astype(jnp.float32)
        dist = jnp.abs(jnp.arange(q0, q1)[:, None] - jnp.arange(q1)[None, :]).astype(jnp.float32)
        logits = jnp.where(_chunk_causal_mask(q0, q1), logits - slopes * dist, -jnp.inf)
        p = jax.nn.softmax(logits, axis=-1)
        a = (p[:, :, 0] - lam_full * p[:, :, 1]).astype(v.dtype)
        return jnp.einsum('bhqk,bkhd->bqhd', a, v[:, :q1])

    o = _sweep_query_blocks(s, block)
    o = _rmsnorm(o, subln_g) * (1.0 - lambda_init)
    return o.reshape(b, s, DIFF_WIDTH) @ w_o


def _mla_shared_kv(x, w_kv_a, kv_norm_g, w_kv_b, cos, sin):
    b, s, _ = x.shape
    kv_a = x @ w_kv_a
    c_kv = _rmsnorm(kv_a[..., :MLA_KV_RANK], kv_norm_g)
    k_rope = _rope(kv_a[..., MLA_KV_RANK:], cos, sin)
    kv = (c_kv @ w_kv_b).reshape(b, s, MLA_HEADS, MLA_NOPE_DIM + MLA_V_DIM)
    return kv[..., :MLA_NOPE_DIM], kv[..., MLA_NOPE_DIM:], k_rope


def _mla_attention(x, w_q_a, q_norm_g, w_q_b, w_o, k_nope, v, k_rope, cos, sin):
    b, s, _ = x.shape
    q = (_rmsnorm(x @ w_q_a, q_norm_g) @ w_q_b).reshape(b, s, MLA_HEADS, MLA_NOPE_DIM + MLA_ROPE_DIM)
    scale = (MLA_NOPE_DIM + MLA_ROPE_DIM) ** -0.5
    q_nope = q[..., :MLA_NOPE_DIM] * scale
    q_rope = _rope(q[..., MLA_NOPE_DIM:], cos[:, None], sin[:, None]) * scale

    def block(q0, q1):
        logits = (jnp.einsum('bqhd,bkhd->bhqk', q_nope[:, q0:q1], k_nope[:, :q1]).astype(jnp.float32)
                  + jnp.einsum('bqhr,bkr->bhqk', q_rope[:, q0:q1], k_rope[:, :q1]).astype(jnp.float32))
        logits = jnp.where(_chunk_causal_mask(q0, q1), logits, -jnp.inf)
        p = jax.nn.softmax(logits, axis=-1).astype(v.dtype)
        return jnp.einsum('bhqk,bkhd->bqhd', p, v[:, :q1])

    o = _sweep_query_blocks(s, block)
    return o.reshape(b, s, MLA_HEADS * MLA_V_DIM) @ w_o


def _grouped_moe(x, router_w, router_b, w_gate, w_up, w_down):
    b, s, d = x.shape
    t = x.reshape(b * s, d)
    scores = jax.nn.sigmoid((t @ router_w).astype(jnp.float32))
    sel = scores + router_b.astype(jnp.float32)
    grouped = sel.reshape(-1, N_GROUPS, N_EXPERTS // N_GROUPS)
    group_score = jnp.sum(lax.top_k(grouped, 2)[0], axis=-1)
    group_mask = jnp.argmax(group_score, axis=-1)[:, None] == jnp.arange(N_GROUPS)[None, :]
    in_group = jnp.where(group_mask[:, :, None], grouped, -jnp.inf).reshape(-1, N_EXPERTS)
    _, idx = lax.top_k(in_group, TOP_K)
    gate = jnp.take_along_axis(scores, idx, axis=-1)
    gate = gate / jnp.sum(gate, axis=-1, keepdims=True)
    combine = jnp.sum(jax.nn.one_hot(idx, N_EXPERTS, dtype=jnp.float32) * gate[..., None], axis=1).astype(t.dtype)
    y = jnp.zeros_like(t)
    for e in range(N_EXPERTS):
        h = jax.nn.silu(t @ w_gate[e]) * (t @ w_up[e])
        y = y + combine[:, e:e + 1] * (h @ w_down[e])
    return y.reshape(b, s, d)


def setup_inputs(seed: int = 0) -> dict:
    key = jax.random.key(seed)
    ks = jax.random.split(key, 19)
    d = D_MODEL

    def nrm(k, shape, scale):
        return jax.random.normal(k, shape, dtype=jnp.float32) * scale

    return {
        'x': nrm(ks[0], (BATCH, SEQ, d), 1.0),
        'diff_w_qkv': nrm(ks[1], (N_A_LAYERS, d, 3 * DIFF_WIDTH), d ** -0.5),
        'diff_lambda': nrm(ks[2], (N_A_LAYERS, 4, DIFF_HEAD_DIM), 0.1),
        'diff_subln_g': 1.0 + nrm(ks[3], (N_A_LAYERS, DIFF_V_DIM), 0.01),
        'diff_w_o': nrm(ks[4], (N_A_LAYERS, DIFF_WIDTH, d), DEEPNORM_BETA * DIFF_WIDTH ** -0.5),
        'mla_w_kv_a': nrm(ks[5], (d, MLA_KV_RANK + MLA_ROPE_DIM), d ** -0.5),
        'mla_kv_norm_g': 1.0 + nrm(ks[6], (MLA_KV_RANK,), 0.01),
        'mla_w_kv_b': nrm(ks[7], (MLA_KV_RANK, MLA_HEADS * (MLA_NOPE_DIM + MLA_V_DIM)), MLA_KV_RANK ** -0.5),
        'mla_w_q_a': nrm(ks[8], (N_B_LAYERS, d, MLA_Q_RANK), d ** -0.5),
        'mla_q_norm_g': 1.0 + nrm(ks[9], (N_B_LAYERS, MLA_Q_RANK), 0.01),
        'mla_w_q_b': nrm(ks[10], (N_B_LAYERS, MLA_Q_RANK, MLA_HEADS * (MLA_NOPE_DIM + MLA_ROPE_DIM)), MLA_Q_RANK ** -0.5),
        'mla_w_o': nrm(ks[11], (N_B_LAYERS, MLA_HEADS * MLA_V_DIM, d), DEEPNORM_BETA * (MLA_HEADS * MLA_V_DIM) ** -0.5),
        'router_w': nrm(ks[12], (d, N_EXPERTS), d ** -0.5),
        'router_b': nrm(ks[13], (N_EXPERTS,), 0.01),
        'moe_w_gate': nrm(ks[14], (DEPTH, N_EXPERTS, d, EXPERT_FF), d ** -0.5),
        'moe_w_up': nrm(ks[15], (DEPTH, N_EXPERTS, d, EXPERT_FF), d ** -0.5),
        'moe_w_down': nrm(ks[16], (DEPTH, N_EXPERTS, EXPERT_FF, d), DEEPNORM_BETA * EXPERT_FF ** -0.5),
        'ln_g': 1.0 + nrm(ks[17], (DEPTH, 2, d), 0.01),
        'ln_b': nrm(ks[18], (DEPTH, 2, d), 0.01),
    }


def reference(x, diff_w_qkv, diff_lambda, diff_subln_g, diff_w_o, mla_w_kv_a, mla_kv_norm_g, mla_w_kv_b,
              mla_w_q_a, mla_q_norm_g, mla_w_q_b, mla_w_o, router_w, router_b, moe_w_gate, moe_w_up,
              moe_w_down, ln_g, ln_b):
    cos, sin = _rope_tables(x.shape[1])
    for layer in range(DEPTH):
        if layer < N_A_LAYERS:
            h = _diff_attention(x, diff_w_qkv[layer], diff_lambda[layer], diff_subln_g[layer],
                                diff_w_o[layer], _lambda_init(layer))
        else:
            if layer == N_A_LAYERS:
                k_nope, v_shared, k_rope = _mla_shared_kv(x, mla_w_kv_a, mla_kv_norm_g, mla_w_kv_b, cos, sin)
            j = layer - N_A_LAYERS
            h = _mla_attention(x, mla_w_q_a[j], mla_q_norm_g[j], mla_w_q_b[j], mla_w_o[j],
                               k_nope, v_shared, k_rope, cos, sin)
        x = _layernorm(DEEPNORM_ALPHA * x + h, ln_g[layer, 0], ln_b[layer, 0])
        f = _grouped_moe(x, router_w, router_b, moe_w_gate[layer], moe_w_up[layer], moe_w_down[layer])
        x = _layernorm(DEEPNORM_ALPHA * x + f, ln_g[layer, 1], ln_b[layer, 1])
    return x
```

```cpp
#include <hip/hip_runtime.h>
#include <cstdio>
#include <cstdint>

#ifndef MK_SINGLE
#define MK_SINGLE 0
#endif

namespace pg8 {
#define PG8_LAS __attribute__((address_space(3)))
typedef unsigned short bf16_t;
typedef short bf16x8 __attribute__((ext_vector_type(8)));
typedef float f32x4 __attribute__((ext_vector_type(4)));
typedef unsigned u32x4 __attribute__((ext_vector_type(4)));
constexpr int BM = 256, BK = 64, HALF = 128, HTB = HALF * BK * 2  , STAGE_BYTES = 8 * HTB, NXCD = 8, WGM = 8;

__host__ __device__ __forceinline__ int lds_byte(int r, int c) { const int st = (r >> 4) * 2 + (c >> 5), rr = r & 15, cc = c & 31, ob = rr * 64 + cc * 2; return st * 1024 + (ob ^ (((ob >> 9) & 1) << 5)); }
__host__ __device__ __forceinline__ void stage_rc(int b, int& R, int& C) { const int st = b / 1024, sb = b % 1024, swz = sb ^ (((sb >> 9) & 1) << 5); R = (st >> 1) * 16 + swz / 64; C = (st & 1) * 32 + (swz % 64) / 2; }
__host__ __device__ __forceinline__ int perm32(int rho) { const int n = rho >> 4, i = rho & 15; return 8 * (i >> 2) + 4 * n + (i & 3); }

struct Unit { int pm, pn; };
struct Gemm { const bf16_t* A; const bf16_t* Bt; int M, N, K; };

struct StaticOrder {
    int nM, nN, nwg, G, c;
    __host__ __device__ void init(int M, int N, int G_, int c_) { nM = M / BM; nN = N / BM; nwg = nM * nN; G = G_; c = c_; }
    __host__ __device__ bool next(int i, Unit& u) const {
        const long L = (long)i * G + c; if (L >= nwg) return false;
        int wgid = (int)L; { const int q = nwg / NXCD, r = nwg % NXCD, xcd = wgid % NXCD, off = wgid / NXCD; wgid = (xcd < r ? xcd * (q + 1) : r * (q + 1) + (xcd - r) * q) + off; }
        const int nig = WGM * nN, gid = wgid / nig, fm = gid * WGM, gsz = (nM - fm) < WGM ? (nM - fm) : WGM;
        u.pm = fm + ((wgid % nig) % gsz); u.pn = (wgid % nig) / gsz; return true;
    }
    __device__ __forceinline__ void a_ready(const Unit&) const {}
    __device__ __forceinline__ void done(const Unit&) const {}
};

__device__ __forceinline__ unsigned cvt_pk_bf16(float lo, float hi) { unsigned r; asm volatile("v_cvt_pk_bf16_f32 %0, %1, %2" : "=v"(r) : "v"(lo), "v"(hi)); return r; }
template <class Epi, class Sched, bool ALIGN_EPI = false, bool SP2 = false>
__device__ __forceinline__ void gemm_phase(PG8_LAS unsigned char* lds, const Gemm g, const Sched& S, const Epi& E) {
    int tid = threadIdx.x; asm volatile("" : "+v"(tid));
    const int wid = __builtin_amdgcn_readfirstlane(tid >> 6), lane = tid & 63, wr = wid >> 2, wc = wid & 3, fr = lane & 15, fq = lane >> 4;
    const int K = g.K, nt = K / BK;
    unsigned voffA[2], voffB[2];
#pragma unroll
    for (int i = 0; i < 2; ++i) { int R, C; stage_rc(tid * 16 + i * 8192, R, C); const int Rb = Epi::PERM ? ((R & ~31) + perm32(R & 31)) : R;
        voffA[i] = (unsigned)(R * K + C) * 2u; voffB[i] = (unsigned)(Rb * K + C) * 2u; }
    const size_t kstep = (size_t)(BK * 2);
    const size_t hstep = (size_t)HALF * K * 2;
    const size_t tstep = 2 * hstep;
    const unsigned ldsw = (unsigned)wid * 1024u;
    const int aoff = lds_byte(wr * 64 + fr, fq * 8), boff = lds_byte(wc * 32 + fr, fq * 8);
#define PG8_SA(b, h) (((b) * 2 + (h)) * HTB)
#define PG8_SB(b, h) ((4 + (b) * 2 + (h)) * HTB)
#define PG8_STAGE(bufoff, gbase, voff) do { _Pragma("unroll") for (int _i = 0; _i < 2; ++_i) \
        __builtin_amdgcn_global_load_lds((const unsigned*)((const char*)(gbase) + (voff)[_i]), (PG8_LAS unsigned*)(lds + (bufoff) + ldsw + _i * 8192), 16, 0, 0); } while (0)
#define PG8_LDA(dst, b, h) do { _Pragma("unroll") for (int m = 0; m < 4; ++m) _Pragma("unroll") for (int k = 0; k < 2; ++k) dst[m][k] = *(const PG8_LAS bf16x8*)(lds + PG8_SA(b, h) + aoff + m * 2048 + k * 1024); } while (0)
#define PG8_LDB(dst, b, h) do { _Pragma("unroll") for (int n = 0; n < 2; ++n) _Pragma("unroll") for (int k = 0; k < 2; ++k) dst[n][k] = *(const PG8_LAS bf16x8*)(lds + PG8_SB(b, h) + boff + n * 2048 + k * 1024); } while (0)
#define PG8_MMA(ai, bj, At, Bt) do { __builtin_amdgcn_s_setprio(1); _Pragma("unroll") for (int m = 0; m < 4; ++m) _Pragma("unroll") for (int n = 0; n < 2; ++n) _Pragma("unroll") for (int k = 0; k < 2; ++k) \
        acc[ai][bj][m][n] = __builtin_amdgcn_mfma_f32_16x16x32_bf16(Bt[n][k], At[m][k], acc[ai][bj][m][n], 0, 0, 0); __builtin_amdgcn_s_setprio(0); } while (0)
#define PG8_WAIT_V(n) asm volatile("s_waitcnt vmcnt(" #n ")" ::: "memory")
#define PG8_WAIT_L(n) asm volatile("s_waitcnt lgkmcnt(" #n ")" ::: "memory")
#define PG8_BAR __builtin_amdgcn_s_barrier()
#define PG8_SCHED __builtin_amdgcn_sched_barrier(0)
    Unit cur, nxt; int ui = 0;
    if (!S.next(0, cur)) return;
    f32x4 acc[2][2][4][2];
#pragma unroll
    for (int a = 0; a < 2; ++a)
#pragma unroll
        for (int b = 0; b < 2; ++b)
#pragma unroll
            for (int m = 0; m < 4; ++m)
#pragma unroll
                for (int n = 0; n < 2; ++n) acc[a][b][m][n] = (f32x4){0.f, 0.f, 0.f, 0.f};
    bf16x8 At[4][2], B0[2][2], B1[2][2];
    const char* cA = (const char*)g.A + (size_t)cur.pm * tstep; const char* cB = (const char*)g.Bt + (size_t)cur.pn * tstep;
    S.a_ready(cur);
    if constexpr (SP2) {
        PG8_STAGE(PG8_SB(0, 0), cB, voffB); PG8_STAGE(PG8_SB(0, 1), cB + hstep, voffB); PG8_STAGE(PG8_SA(0, 0), cA, voffA); PG8_STAGE(PG8_SA(0, 1), cA + hstep, voffA);
        if (wr == 1) PG8_BAR;
        PG8_WAIT_V(2); PG8_BAR;
        PG8_STAGE(PG8_SB(1, 0), cB + kstep, voffB); PG8_STAGE(PG8_SA(1, 0), cA + kstep, voffA); PG8_STAGE(PG8_SB(1, 1), cB + hstep + kstep, voffB);
        PG8_WAIT_V(6); PG8_BAR;
    } else {
        PG8_STAGE(PG8_SB(0, 0), cB, voffB); PG8_STAGE(PG8_SA(0, 0), cA, voffA); PG8_STAGE(PG8_SB(0, 1), cB + hstep, voffB); PG8_STAGE(PG8_SA(0, 1), cA + hstep, voffA);
        if (wr == 1) PG8_BAR;
        PG8_WAIT_V(4); PG8_BAR;
        PG8_STAGE(PG8_SB(1, 0), cB + kstep, voffB); PG8_STAGE(PG8_SA(1, 0), cA + kstep, voffA); PG8_STAGE(PG8_SB(1, 1), cB + hstep + kstep, voffB);
        PG8_WAIT_V(6); PG8_BAR;
    }
    for (;;) {
        const bool has_next = S.next(ui + 1, nxt);
        const char* nA = has_next ? (const char*)g.A + (size_t)nxt.pm * tstep : cA; const char* nB = has_next ? (const char*)g.Bt + (size_t)nxt.pn * tstep : cB;
        for (int t = 0; t < nt; t += 2) {
            const bool last = (t == nt - 2);
            const char* a1 = cA + (size_t)(t + 1) * kstep;
            const char* a2 = last ? nA : cA + (size_t)(t + 2) * kstep; const char* b2 = last ? nB : cB + (size_t)(t + 2) * kstep;
            const char* a3 = a2 + kstep; const char* b3 = b2 + kstep;
            if (last && has_next) S.a_ready(nxt);
            if constexpr (SP2) {
            PG8_LDB(B0, 0, 0); PG8_LDB(B1, 0, 1); PG8_SCHED; PG8_LDA(At, 0, 0); PG8_STAGE(PG8_SA(1, 1), a1 + hstep, voffA);
            PG8_WAIT_V(8); PG8_WAIT_L(0); PG8_BAR; PG8_MMA(0, 0, At, B0); PG8_MMA(0, 1, At, B1); PG8_BAR; PG8_SCHED;
            PG8_LDA(At, 0, 1); PG8_STAGE(PG8_SB(0, 0), b2, voffB); PG8_STAGE(PG8_SB(0, 1), b2 + hstep, voffB); PG8_STAGE(PG8_SA(0, 0), a2, voffA);
            PG8_WAIT_V(8); PG8_WAIT_L(0); PG8_BAR; PG8_MMA(1, 0, At, B0); PG8_MMA(1, 1, At, B1); PG8_BAR; PG8_SCHED;
            PG8_LDB(B0, 1, 0); PG8_LDB(B1, 1, 1); PG8_SCHED; PG8_LDA(At, 1, 0); PG8_STAGE(PG8_SA(0, 1), a2 + hstep, voffA);
            PG8_WAIT_V(8); PG8_WAIT_L(0); PG8_BAR; PG8_MMA(0, 0, At, B0); PG8_MMA(0, 1, At, B1); PG8_BAR; PG8_SCHED;
            PG8_LDA(At, 1, 1); PG8_STAGE(PG8_SB(1, 0), b3, voffB); PG8_STAGE(PG8_SB(1, 1), b3 + hstep, voffB); PG8_STAGE(PG8_SA(1, 0), a3, voffA);
            PG8_WAIT_V(8); PG8_WAIT_L(0); PG8_BAR; PG8_MMA(1, 0, At, B0); PG8_MMA(1, 1, At, B1); PG8_BAR; PG8_SCHED;
            } else {
            PG8_LDB(B0, 0, 0); PG8_SCHED; PG8_LDA(At, 0, 0); PG8_STAGE(PG8_SA(1, 1), a1 + hstep, voffA);
            PG8_WAIT_L(8); PG8_BAR; PG8_WAIT_L(0); PG8_MMA(0, 0, At, B0); PG8_BAR; PG8_SCHED;
            PG8_LDB(B1, 0, 1); PG8_STAGE(PG8_SB(0, 0), b2, voffB);
            PG8_BAR; PG8_WAIT_L(0); PG8_MMA(0, 1, At, B1); PG8_BAR;
            PG8_LDA(At, 0, 1); PG8_STAGE(PG8_SA(0, 0), a2, voffA);
            PG8_BAR; PG8_WAIT_L(0); PG8_MMA(1, 0, At, B0); PG8_BAR; PG8_SCHED;
            PG8_STAGE(PG8_SB(0, 1), b2 + hstep, voffB);
            PG8_WAIT_V(6); PG8_BAR; PG8_MMA(1, 1, At, B1); PG8_BAR;
            PG8_LDB(B0, 1, 0); PG8_SCHED; PG8_LDA(At, 1, 0); PG8_STAGE(PG8_SA(0, 1), a2 + hstep, voffA);
            PG8_WAIT_L(8); PG8_BAR; PG8_WAIT_L(0); PG8_MMA(0, 0, At, B0); PG8_BAR; PG8_SCHED;
            PG8_LDB(B1, 1, 1); PG8_STAGE(PG8_SB(1, 0), b3, voffB);
            PG8_BAR; PG8_WAIT_L(0); PG8_MMA(0, 1, At, B1); PG8_BAR;
            PG8_LDA(At, 1, 1); PG8_STAGE(PG8_SA(1, 0), a3, voffA);
            PG8_BAR; PG8_WAIT_L(0); PG8_MMA(1, 0, At, B0); PG8_BAR; PG8_SCHED;
            PG8_STAGE(PG8_SB(1, 1), b3 + hstep, voffB);
            PG8_WAIT_V(6); PG8_BAR; PG8_MMA(1, 1, At, B1); PG8_BAR;
            }
        }
        if constexpr (ALIGN_EPI) { if (wr == 0) PG8_BAR; }
        if constexpr (!Epi::AFTER_DRAIN) { E(acc, cur, wr, wc, fr, fq); S.done(cur); }
        if (!has_next) break;
#pragma unroll
        for (int a = 0; a < 2; ++a)
#pragma unroll
            for (int b = 0; b < 2; ++b)
#pragma unroll
                for (int m = 0; m < 4; ++m)
#pragma unroll
                    for (int n = 0; n < 2; ++n) acc[a][b][m][n] = (f32x4){0.f, 0.f, 0.f, 0.f};
        cur = nxt; cA = nA; cB = nB; ++ui;
        if constexpr (ALIGN_EPI) { if (wr == 1) PG8_BAR; }
    }
    PG8_WAIT_V(0);
    if constexpr (!ALIGN_EPI) { if (wr == 0) PG8_BAR; }
    PG8_BAR;
    if constexpr (Epi::AFTER_DRAIN) { E.fused(acc, cur, wr, wc, fr, fq, lds, wid, lane); S.done(cur); }
#undef PG8_SA
#undef PG8_SB
#undef PG8_STAGE
#undef PG8_LDA
#undef PG8_LDB
#undef PG8_MMA
#undef PG8_WAIT_V
#undef PG8_WAIT_L
#undef PG8_BAR
#undef PG8_SCHED
}
}

#define LAS __attribute__((address_space(3)))
typedef unsigned short bf16;
typedef short bf16x8 __attribute__((ext_vector_type(8)));
typedef short s16x4 __attribute__((ext_vector_type(4)));
typedef float f32x4 __attribute__((ext_vector_type(4)));
typedef float f32x16 __attribute__((ext_vector_type(16)));
typedef unsigned u32x4 __attribute__((ext_vector_type(4)));
typedef unsigned u32x2 __attribute__((ext_vector_type(2)));

constexpr int T = 16384, D = 1024, SEQ = 4096, NBATCH = 4, NE = 32, FFE = 256;
constexpr int NWAVES = 8, NTHREADS = 512, GRID = 256;
constexpr float LN_EPS = 1e-5f, ALPHA = 1.6817928305074290f;
constexpr float LOG2E = 1.4426950408889634f;
constexpr int SLOT_CAP = 40960, MAXPANELS = SLOT_CAP / 256;
constexpr int RPW = T / GRID;

constexpr size_t MiB = 1u << 20, KiB = 1u << 10;
constexpr size_t WS_CTL = 0, CTL_ZERO_BYTES = 64 * KiB;
constexpr size_t WS_COS = 1 * MiB, WS_SIN = WS_COS + 512 * KiB;
constexpr size_t WS_SSQQ = 2 * MiB;
constexpr size_t WS_SSQKV = WS_SSQQ + 512 * KiB;
constexpr size_t WS_TKE = 3 * MiB, WS_TKRANK = WS_TKE + 128 * KiB, WS_TKGATE = WS_TKRANK + 128 * KiB, WS_TOKSLOT = WS_TKGATE + 128 * KiB;
constexpr size_t WS_SLOTGATE = WS_TOKSLOT + 128 * KiB;
constexpr size_t WS_WGCNT = WS_SLOTGATE + 160 * KiB;
constexpr size_t WS_PANEL = WS_WGCNT + 32 * KiB;
constexpr size_t WS_WQKV = 4 * MiB;
constexpr size_t WS_WO = 16 * MiB;
constexpr size_t WS_WA0 = 20 * MiB, WS_WA1 = 22 * MiB;
constexpr size_t WS_WQB = 23 * MiB, WQB_STRIDE = 1280 * KiB;
constexpr size_t WS_WKVB = 26 * MiB;
constexpr size_t WS_WMO = 27 * MiB;
constexpr size_t WS_MOEGU = 32 * MiB;
constexpr size_t WS_MOED = 64 * MiB;
constexpr size_t WS_X16 = 80 * MiB;
constexpr size_t WS_RA = 112 * MiB;
constexpr size_t WS_RB = 216 * MiB;
constexpr size_t WS_Y = 282 * MiB;
constexpr size_t WS_END = 362 * MiB;
constexpr size_t RA_QKV = 0, RA_O_DIFF = 0, RA_Q = 0, RA_O_MLA = 48 * MiB, RA_QA = 80 * MiB, RA_CKV = 92 * MiB, RA_XS = 0, RA_H = 80 * MiB;
constexpr size_t RB_OC = 0, RB_KV = 0, RB_KROPE = 64 * MiB;

constexpr int LDS_MAIN = 131584;
constexpr int MISC_OFF = LDS_MAIN;
constexpr int LDS_BYTES = LDS_MAIN + 512;

#define LDS_WAIT() asm volatile("s_waitcnt lgkmcnt(0)" ::: "memory")
#define VM_WAIT() asm volatile("s_waitcnt vmcnt(0)" ::: "memory")
__device__ __forceinline__ unsigned cvtpk(float lo, float hi) { unsigned r; asm volatile("v_cvt_pk_bf16_f32 %0, %1, %2" : "=v"(r) : "v"(lo), "v"(hi)); return r; }
__device__ __forceinline__ float bf_lo(unsigned w) { return __uint_as_float(w << 16); }
__device__ __forceinline__ float bf_hi(unsigned w) { return __uint_as_float(w & 0xffff0000u); }
__device__ __forceinline__ float wave_sum(float v) {
#pragma unroll
    for (int o = 1; o < 64; o <<= 1) v += __shfl_xor(v, o);
    return v;
}

#define XB_TMO      128
#define XB_XCNT(j)  (256  + 64 * (j))
#define XB_XSUB(j)  (1280 + 64 * (j))
#define XB_XGEN(j)  (2304 + 64 * (j))
#define XB_TOP      3328
#define XB_TOPGEN   3392
#define XCD_BAR_WORDS 3456
#define XB_SPIN_CAP (1u << 18)

__device__ __forceinline__ unsigned xb_ld(unsigned* p)              { return __hip_atomic_load(p, __ATOMIC_RELAXED, __HIP_MEMORY_SCOPE_AGENT); }
__device__ __forceinline__ unsigned xb_add(unsigned* p, unsigned v) { return __hip_atomic_fetch_add(p, v, __ATOMIC_RELAXED, __HIP_MEMORY_SCOPE_AGENT); }
__device__ __forceinline__ unsigned xb_xcc_id() { return (unsigned)__builtin_amdgcn_s_getreg((3 << 11) | 20) & 0xFu; }
#define XB_SPIN(cond, bar) do { unsigned _sp = 0; while (cond) { __builtin_amdgcn_s_sleep(1); \
    if ((++_sp & 255u) == 0u) { if (xb_ld(&(bar)[XB_TMO])) break; if (_sp > XB_SPIN_CAP) { atomicAdd(&(bar)[XB_TMO], 1u); break; } } } } while (0)

struct XcdBarrier {
    unsigned* bar; unsigned x;
    volatile LAS unsigned* st;
};
__device__ __forceinline__ XcdBarrier xcd_barrier_post(unsigned* bar, volatile LAS unsigned* st) {
    XcdBarrier b; b.bar = bar; b.x = xb_xcc_id(); b.st = st;
    if (threadIdx.x == 0) (void)xb_add(&bar[XB_XCNT(b.x)], 1u);
    return b;
}
__device__ __forceinline__ void xcd_barrier_complete(unsigned* bar, unsigned x, unsigned& nloc, unsigned& nx) {
    const unsigned G = gridDim.x * gridDim.y * gridDim.z;
    unsigned sum, cnt, mine, sp = 0u;
    for (;;) {
        sum = 0u; cnt = 0u; mine = 0u;
#pragma unroll
        for (unsigned j = 0; j < 16; ++j) { const unsigned c = xb_ld(&bar[XB_XCNT(j)]); sum += c; cnt += (c > 0u) ? 1u : 0u; mine = (j == x) ? c : mine; }
        if (sum == G) break;
        __builtin_amdgcn_s_sleep(1);
        if ((++sp & 255u) == 0u) { if (xb_ld(&bar[XB_TMO])) break; if (sp > XB_SPIN_CAP) { atomicAdd(&bar[XB_TMO], 1u); break; } }
    }
    nloc = mine > 0u ? mine : 1u; nx = cnt > 0u ? cnt : 1u;
}
__device__ __forceinline__ void xcd_barrier(const XcdBarrier& b) {
    asm volatile("s_waitcnt vmcnt(0)" ::: "memory");
    __syncthreads();
    if (threadIdx.x == 0) {
        unsigned* bar = b.bar; asm volatile("" : "+s"(bar));
        __builtin_amdgcn_s_waitcnt(0);
        unsigned nloc = b.st[0], nx = b.st[1];
        if (nloc == 0u) { xcd_barrier_complete(bar, b.x, nloc, nx); b.st[0] = nloc; b.st[1] = nx; }
        const unsigned old = xb_add(&bar[XB_XSUB(b.x)], 1u);
        const unsigned gen = old / nloc;
        if (old + 1u == (gen + 1u) * nloc) {
            __builtin_amdgcn_fence(__ATOMIC_RELEASE, "agent");
            asm volatile("s_waitcnt vmcnt(0)" ::: "memory");
            const unsigned og = xb_add(&bar[XB_TOP], 1u);
            const unsigned tg = og / nx;
            if (og + 1u == (tg + 1u) * nx) xb_add(&bar[XB_TOPGEN], 1u);
            else XB_SPIN(xb_ld(&bar[XB_TOPGEN]) == tg, bar);
            __builtin_amdgcn_fence(__ATOMIC_ACQUIRE, "agent");
            xb_add(&bar[XB_XGEN(b.x)], 1u);
            asm volatile("s_waitcnt vmcnt(0)" ::: "memory");
        } else {
            XB_SPIN(xb_ld(&bar[XB_XGEN(b.x)]) == gen, bar);
            __builtin_amdgcn_fence(__ATOMIC_ACQUIRE, "agent");
            asm volatile("s_waitcnt vmcnt(0)" ::: "memory");
        }
    }
    __syncthreads();
}

typedef const f32x4 (&AccRef)[2][2][4][2];

struct MoeOrder {
    const int* panel_e; int nt, nunits, G, c;
    __device__ void init(const int* pe, int nt_, int G_, int c_) { panel_e = pe; nt = nt_; nunits = pe[MAXPANELS] * nt_; G = G_; c = c_; }
    __device__ bool next(int i, pg8::Unit& u) const {
        const long L = (long)i * G + c; if (L >= nunits) return false;
        const int pm = (int)L / nt, t = (int)L % nt; u.pm = pm; u.pn = panel_e[pm] * nt + t; return true;
    }
    __device__ __forceinline__ void a_ready(const pg8::Unit&) const {}
    __device__ __forceinline__ void done(const pg8::Unit&) const {}
};

__device__ __forceinline__ u32x4 pack8(const f32x4 v0, const f32x4 v1) { u32x4 w; w.x = cvtpk(v0[0], v0[1]); w.y = cvtpk(v0[2], v0[3]); w.z = cvtpk(v1[0], v1[1]); w.w = cvtpk(v1[2], v1[3]); return w; }

struct EpiStore {
    static constexpr bool PERM = true, AFTER_DRAIN = false;
    bf16* O; int ldc;
    __device__ __forceinline__ void operator()(AccRef acc, const pg8::Unit& u, int wr, int wc, int fr, int fq) const {
        const int row0 = u.pm * 256 + wr * 64 + fr, col0 = u.pn * 256 + wc * 32 + 8 * fq;
#pragma unroll
        for (int ai = 0; ai < 2; ++ai)
#pragma unroll
            for (int m = 0; m < 4; ++m) { bf16* rowp = O + (size_t)(row0 + ai * 128 + m * 16) * ldc + col0;
#pragma unroll
                for (int bj = 0; bj < 2; ++bj) *(u32x4*)(rowp + bj * 128) = pack8(acc[ai][bj][m][0], acc[ai][bj][m][1]); }
    }
};
struct EpiRes {
    static constexpr bool PERM = false, AFTER_DRAIN = false;
    const float* res; float* out;
    __device__ __forceinline__ void operator()(AccRef acc, const pg8::Unit& u, int wr, int wc, int fr, int fq) const {
        const int row0 = u.pm * 256 + wr * 64 + fr, col0 = u.pn * 256 + wc * 32 + 4 * fq;
#pragma unroll
        for (int ai = 0; ai < 2; ++ai)
#pragma unroll
            for (int m = 0; m < 4; ++m) { const size_t off = (size_t)(row0 + ai * 128 + m * 16) * D + col0;
#pragma unroll
                for (int bj = 0; bj < 2; ++bj)
#pragma unroll
                    for (int n = 0; n < 2; ++n) { const f32x4 r = *(const f32x4*)(res + off + bj * 128 + n * 16); *(f32x4*)(out + off + bj * 128 + n * 16) = r * ALPHA + acc[ai][bj][m][n]; } }
    }
};
__device__ __forceinline__ void rope8(f32x4& v0, f32x4& v1, const f32x4 c, const f32x4 s) {
    float a, b;
    a = v0[0]; b = v0[1]; v0[0] = a * c[0] - b * s[0]; v0[1] = b * c[0] + a * s[0];
    a = v0[2]; b = v0[3]; v0[2] = a * c[1] - b * s[1]; v0[3] = b * c[1] + a * s[1];
    a = v1[0]; b = v1[1]; v1[0] = a * c[2] - b * s[2]; v1[1] = b * c[2] + a * s[2];
    a = v1[2]; b = v1[3]; v1[2] = a * c[3] - b * s[3]; v1[3] = b * c[3] + a * s[3];
}
struct EpiMlaA {
    static constexpr bool PERM = true, AFTER_DRAIN = false;
    bf16* qa; bf16* ckv; bf16* krope; float* ssq_q; float* ssq_kv; const float* cosT; const float* sinT;
    __device__ __forceinline__ void operator()(AccRef acc, const pg8::Unit& u, int wr, int wc, int fr, int fq) const {
        const int row0 = u.pm * 256 + wr * 64 + fr, c8 = wc * 32 + 8 * fq;
        if (u.pn <= 2) {
            bf16* O = (u.pn == 2) ? ckv : qa; const int ld = (u.pn == 2) ? 256 : 384, cbase = (u.pn == 1) ? 256 : 0, nbj = (u.pn == 1) ? 1 : 2;
            float* sp = (u.pn == 2) ? ssq_kv : ssq_q; const int sstr = (u.pn == 2) ? 4 : 8, sidx = (u.pn == 1) ? 4 + wc : wc;
#pragma unroll
            for (int ai = 0; ai < 2; ++ai)
#pragma unroll
                for (int m = 0; m < 4; ++m) { const int row = row0 + ai * 128 + m * 16; float s = 0.f;
#pragma unroll
                    for (int bj = 0; bj < 2; ++bj) if (bj < nbj) { const f32x4 v0 = acc[ai][bj][m][0], v1 = acc[ai][bj][m][1];
                        s += (v0[0] * v0[0] + v0[1] * v0[1]) + (v0[2] * v0[2] + v0[3] * v0[3]) + (v1[0] * v1[0] + v1[1] * v1[1]) + (v1[2] * v1[2] + v1[3] * v1[3]);
                        *(u32x4*)(O + (size_t)row * ld + cbase + bj * 128 + c8) = pack8(v0, v1); }
                    s += __shfl_xor(s, 16); s += __shfl_xor(s, 32);
                    if (fq == 0) sp[(size_t)row * sstr + sidx] = s; }
        } else if (wc < 2) {
#pragma unroll
            for (int ai = 0; ai < 2; ++ai)
#pragma unroll
                for (int m = 0; m < 4; ++m) { const int row = row0 + ai * 128 + m * 16, pos = row & (SEQ - 1);
                    f32x4 v0 = acc[ai][0][m][0], v1 = acc[ai][0][m][1];
                    const f32x4 c = *(const f32x4*)(cosT + pos * 32 + (c8 >> 1)), s = *(const f32x4*)(sinT + pos * 32 + (c8 >> 1));
                    rope8(v0, v1, c, s);
                    *(u32x4*)(krope + (size_t)row * 64 + c8) = pack8(v0, v1); }
        }
    }
};
struct EpiQB {
    static constexpr bool PERM = true, AFTER_DRAIN = false;
    bf16* q; const float* ssq_q; const float* cosT; const float* sinT; float qscale;
    __device__ __forceinline__ void operator()(AccRef acc, const pg8::Unit& u, int wr, int wc, int fr, int fq) const {
        const int row0 = u.pm * 256 + wr * 64 + fr, c8 = wc * 32 + 8 * fq;
#pragma unroll
        for (int ai = 0; ai < 2; ++ai)
#pragma unroll
            for (int m = 0; m < 4; ++m) { const int row = row0 + ai * 128 + m * 16, pos = row & (SEQ - 1);
                const f32x4 pa = *(const f32x4*)(ssq_q + (size_t)row * 8), pb = *(const f32x4*)(ssq_q + (size_t)row * 8 + 4);
                const float ss = ((pa[0] + pa[1]) + (pa[2] + pa[3])) + ((pb[0] + pb[1]) + (pb[2] + pb[3]));
                const float rs = qscale / sqrtf(ss * (1.0f / 384.0f) + LN_EPS);
#pragma unroll
                for (int bj = 0; bj < 2; ++bj) { const int col = u.pn * 256 + bj * 128 + c8, head = col / 192, within = col - head * 192;
                    f32x4 v0 = acc[ai][bj][m][0] * rs, v1 = acc[ai][bj][m][1] * rs;
                    if (within >= 128) { const int i0 = (within - 128) >> 1;
                        const f32x4 c = *(const f32x4*)(cosT + pos * 32 + i0), s = *(const f32x4*)(sinT + pos * 32 + i0); rope8(v0, v1, c, s); }
                    *(u32x4*)(q + (size_t)row * 1536 + col) = pack8(v0, v1); } }
    }
};
struct EpiKVB {
    static constexpr bool PERM = true, AFTER_DRAIN = false;
    bf16* kv; const float* ssq_kv;
    __device__ __forceinline__ void operator()(AccRef acc, const pg8::Unit& u, int wr, int wc, int fr, int fq) const {
        const int row0 = u.pm * 256 + wr * 64 + fr, col0 = u.pn * 256 + wc * 32 + 8 * fq;
#pragma unroll
        for (int ai = 0; ai < 2; ++ai)
#pragma unroll
            for (int m = 0; m < 4; ++m) { const int row = row0 + ai * 128 + m * 16;
                const f32x4 pa = *(const f32x4*)(ssq_kv + (size_t)row * 4);
                const float rs = 1.0f / sqrtf(((pa[0] + pa[1]) + (pa[2] + pa[3])) * (1.0f / 256.0f) + LN_EPS);
#pragma unroll
                for (int bj = 0; bj < 2; ++bj) *(u32x4*)(kv + (size_t)row * 2048 + col0 + bj * 128) = pack8(acc[ai][bj][m][0] * rs, acc[ai][bj][m][1] * rs); }
    }
};
__device__ __forceinline__ float silu_mul(float g, float u) { return g * u / (1.0f + __builtin_amdgcn_exp2f(-g * LOG2E)); }
struct EpiUp {
    static constexpr bool PERM = true, AFTER_DRAIN = false;
    bf16* h;
    __device__ __forceinline__ void operator()(AccRef acc, const pg8::Unit& u, int wr, int wc, int fr, int fq) const {
        const int row0 = u.pm * 256 + wr * 64 + fr, col0 = (u.pn & 1) * 128 + wc * 32 + 8 * fq;
#pragma unroll
        for (int ai = 0; ai < 2; ++ai)
#pragma unroll
            for (int m = 0; m < 4; ++m) { f32x4 v0, v1;
#pragma unroll
                for (int i = 0; i < 4; ++i) { v0[i] = silu_mul(acc[ai][0][m][0][i], acc[ai][1][m][0][i]); v1[i] = silu_mul(acc[ai][0][m][1][i], acc[ai][1][m][1][i]); }
                *(u32x4*)(h + (size_t)(row0 + ai * 128 + m * 16) * FFE + col0) = pack8(v0, v1); }
    }
};
struct EpiDown {
    static constexpr bool PERM = true, AFTER_DRAIN = false;
    bf16* y; const float* gate;
    __device__ __forceinline__ void operator()(AccRef acc, const pg8::Unit& u, int wr, int wc, int fr, int fq) const {
        const int row0 = u.pm * 256 + wr * 64 + fr, col0 = (u.pn & 3) * 256 + wc * 32 + 8 * fq;
#pragma unroll
        for (int ai = 0; ai < 2; ++ai)
#pragma unroll
            for (int m = 0; m < 4; ++m) { const int row = row0 + ai * 128 + m * 16; const float g = gate[row];
#pragma unroll
                for (int bj = 0; bj < 2; ++bj) *(u32x4*)(y + (size_t)row * D + col0 + bj * 128) = pack8(acc[ai][bj][m][0] * g, acc[ai][bj][m][1] * g); }
    }
};

namespace att {
__device__ __forceinline__ int crow(int r, int hi) { return (r & 3) + 8 * (r >> 2) + 4 * hi; }
__device__ __forceinline__ int v_st(int k, int c) { const int kk = (k & ~0xC) | ((k & 4) << 1) | ((k & 8) >> 1); return ((kk >> 3) * 4 + (c >> 5)) * 512 + ((kk & 7) * 32 + (c & 31)) * 2; }
__device__ __forceinline__ int v_rd_base(int lane) { return ((lane & 3) << 3) | (((lane >> 2) & 3) << 6) | (((lane >> 4) & 1) << 5) | (((lane >> 5) & 1) << 8); }
constexpr int v_rd_off(int d0, int ks, int half) { return d0 * 512 + ks * 4096 + half * 2048; }
template <int OFF> __device__ __forceinline__ s16x4 tr_read(unsigned vb) {
    s16x4 r; asm volatile("ds_read_b64_tr_b16 %0, %1 offset:%2" : "=&v"(r) : "v"(vb), "i"(OFF) : "memory"); return r;
}
template <int D0> __device__ __forceinline__ void pv_one(f32x16& od, unsigned vb, bf16x8 pa0, bf16x8 pa1, bf16x8 pa2, bf16x8 pa3) {
    const s16x4 l0 = tr_read<v_rd_off(D0, 0, 0)>(vb), h0 = tr_read<v_rd_off(D0, 0, 1)>(vb), l1 = tr_read<v_rd_off(D0, 1, 0)>(vb), h1 = tr_read<v_rd_off(D0, 1, 1)>(vb);
    const s16x4 l2 = tr_read<v_rd_off(D0, 2, 0)>(vb), h2 = tr_read<v_rd_off(D0, 2, 1)>(vb), l3 = tr_read<v_rd_off(D0, 3, 0)>(vb), h3 = tr_read<v_rd_off(D0, 3, 1)>(vb);
    asm volatile("s_waitcnt lgkmcnt(0)" ::: "memory"); __builtin_amdgcn_sched_barrier(0);
#define ATT_PK(L, H) (bf16x8){L[0], L[1], L[2], L[3], H[0], H[1], H[2], H[3]}
    od = __builtin_amdgcn_mfma_f32_32x32x16_bf16(pa0, ATT_PK(l0, h0), od, 0, 0, 0);
    od = __builtin_amdgcn_mfma_f32_32x32x16_bf16(pa1, ATT_PK(l1, h1), od, 0, 0, 0);
    od = __builtin_amdgcn_mfma_f32_32x32x16_bf16(pa2, ATT_PK(l2, h2), od, 0, 0, 0);
    od = __builtin_amdgcn_mfma_f32_32x32x16_bf16(pa3, ATT_PK(l3, h3), od, 0, 0, 0);
#undef ATT_PK
}
template <int DQK> __device__ __forceinline__ int k_off(int row, int c) { return row * (DQK * 2) + (((c & ~7) | ((c ^ (row >> 1)) & 7)) << 4); }

template <int DQK, bool ALIBI>
__device__ __forceinline__ void unit(const bf16* Q, int ldq, const bf16* K1, int ldk1, const bf16* K2, int ldk2, const bf16* V, int ldv,
                                     bf16* O, int ldo, int qb, float slope2, LAS unsigned char* lds) {
    constexpr int NCH = DQK / 8, KPT = NCH / 8, KT = 64 * DQK * 2, VT = 16384, NKS = DQK / 16;
    int tid = threadIdx.x; asm volatile("" : "+v"(tid));
    const int wid = __builtin_amdgcn_readfirstlane(tid >> 6), lane = tid & 63, r32 = lane & 31, hi = lane >> 5;
    LAS unsigned char* Kl = lds; LAS unsigned char* Vl = lds + 2 * KT; LAS float* ws = (LAS float*)(lds + 2 * KT + 2 * VT) + wid * 64;
    bf16x8 qr[NKS];
    { const bf16* Qw = Q + (size_t)(wid * 32 + r32) * ldq + hi * 8;
#pragma unroll
      for (int d0 = 0; d0 < NKS; ++d0) qr[d0] = *(const bf16x8*)(Qw + d0 * 16); }
    const int sr = tid >> 4, sc = (tid & 15) * 8, vst0 = v_st(sr, sc), vst1 = v_st(32 + sr, sc);
    const bf16* vp0 = V + (size_t)sr * ldv + sc; const bf16* vp1 = V + (size_t)(32 + sr) * ldv + sc;
    const bf16* kp[KPT]; int kld[KPT], kdst[KPT];
#pragma unroll
    for (int i = 0; i < KPT; ++i) { const int idx = tid + 512 * i, row = idx / NCH, c = idx % NCH;
        kdst[i] = k_off<DQK>(row, c);
        if (DQK > 128 && c >= 16) { kp[i] = K2 + (size_t)row * ldk2 + (c - 16) * 8; kld[i] = ldk2; } else { kp[i] = K1 + (size_t)row * ldk1 + c * 8; kld[i] = ldk1; } }
    bf16x8 vs0, vs1, ks[KPT];
#define ATT_GLOAD(j) do { const size_t _k0 = (size_t)(j) * 64; vs0 = *(const bf16x8*)(vp0 + _k0 * ldv); vs1 = *(const bf16x8*)(vp1 + _k0 * ldv); \
    _Pragma("unroll") for (int _i = 0; _i < KPT; ++_i) ks[_i] = *(const bf16x8*)(kp[_i] + _k0 * kld[_i]); } while (0)
#define ATT_LWRITE(b) do { *(LAS bf16x8*)(Vl + (b) * VT + vst0) = vs0; *(LAS bf16x8*)(Vl + (b) * VT + vst1) = vs1; \
    _Pragma("unroll") for (int _i = 0; _i < KPT; ++_i) *(LAS bf16x8*)(Kl + (b) * KT + kdst[_i]) = ks[_i]; } while (0)
    const unsigned vb0 = (unsigned)(size_t)Vl + (unsigned)v_rd_base(lane);
    const int swz = (r32 >> 1) & 7;
    f32x16 o[4];
#pragma unroll
    for (int d = 0; d < 4; ++d)
#pragma unroll
        for (int r = 0; r < 16; ++r) o[d][r] = 0.f;
    float m_reg = -1e30f, l_reg = 0.f;
    const int NT = 4 * qb + 4, jmax = 4 * qb + (wid >> 1), qpos = qb * 256 + wid * 32 + r32;
    ATT_GLOAD(0); ATT_LWRITE(0); __syncthreads();
    for (int j = 0; j < NT; ++j) {
        const int cur = j & 1;
        if (j + 1 < NT) ATT_GLOAD(j + 1);
        if (j <= jmax) {
            f32x16 p0, p1;
#pragma unroll
            for (int r = 0; r < 16; ++r) { p0[r] = 0.f; p1[r] = 0.f; }
            const LAS unsigned char* Kc = Kl + cur * KT;
#pragma unroll
            for (int d0 = 0; d0 < NKS; ++d0) { const int c = d0 * 2 + hi, cs = ((c & ~7) | ((c ^ swz) & 7)) << 4;
                const bf16x8 b0 = *(const LAS bf16x8*)(Kc + r32 * (DQK * 2) + cs), b1 = *(const LAS bf16x8*)(Kc + (32 + r32) * (DQK * 2) + cs);
                p0 = __builtin_amdgcn_mfma_f32_32x32x16_bf16(b0, qr[d0], p0, 0, 0, 0);
                p1 = __builtin_amdgcn_mfma_f32_32x32x16_bf16(b1, qr[d0], p1, 0, 0, 0); }
            if (ALIBI) { const float dq = (float)(qpos - 64 * j - 4 * hi);
#pragma unroll
                for (int r = 0; r < 16; ++r) { const float ko = (float)((r & 3) + 8 * (r >> 2));
                    p0[r] = fmaf(-slope2, fabsf(dq - ko), p0[r]); p1[r] = fmaf(-slope2, fabsf(dq - ko - 32.f), p1[r]); } }
            float pmax = p0[0];
#pragma unroll
            for (int r = 1; r < 16; ++r) pmax = fmaxf(pmax, p0[r]);
#pragma unroll
            for (int r = 0; r < 16; ++r) pmax = fmaxf(pmax, p1[r]);
            { auto rr = __builtin_amdgcn_permlane32_swap(__float_as_uint(pmax), __float_as_uint(pmax), false, false);
              pmax = fmaxf(__uint_as_float(rr[0]), __uint_as_float(rr[1])); }
            const float mn = fmaxf(m_reg, pmax), alpha = __builtin_amdgcn_exp2f(m_reg - mn); m_reg = mn;
            float ps = 0.f;
#pragma unroll
            for (int r = 0; r < 16; ++r) { p0[r] = __builtin_amdgcn_exp2f(p0[r] - mn); p1[r] = __builtin_amdgcn_exp2f(p1[r] - mn); ps += p0[r] + p1[r]; }
            { auto rr = __builtin_amdgcn_permlane32_swap(__float_as_uint(ps), __float_as_uint(ps), false, false);
              ps = __uint_as_float(rr[0]) + __uint_as_float(rr[1]); }
            l_reg = l_reg * alpha + ps;
            if (__builtin_amdgcn_ballot_w64(alpha < 1.f) != 0ull) {
                if (hi == 0) ws[r32] = alpha;
                LDS_WAIT();
#pragma unroll
                for (int r = 0; r < 16; ++r) { const float a = ws[crow(r, hi)];
#pragma unroll
                    for (int d = 0; d < 4; ++d) o[d][r] *= a; }
            }
            bf16x8 pa0, pa1, pa2, pa3;
#define ATT_PK4(P, BASE, OUT) do { unsigned a0 = cvtpk(P[BASE + 0], P[BASE + 1]), a1 = cvtpk(P[BASE + 2], P[BASE + 3]);   \
    unsigned b0_ = cvtpk(P[BASE + 4], P[BASE + 5]), b1_ = cvtpk(P[BASE + 6], P[BASE + 7]);                              \
    auto r0 = __builtin_amdgcn_permlane32_swap(a0, b0_, false, false); auto r1 = __builtin_amdgcn_permlane32_swap(a1, b1_, false, false); \
    u32x4 w = {r0[0], r1[0], r0[1], r1[1]}; OUT = __builtin_bit_cast(bf16x8, w); } while (0)
            ATT_PK4(p0, 0, pa0); ATT_PK4(p0, 8, pa1); ATT_PK4(p1, 0, pa2); ATT_PK4(p1, 8, pa3);
#undef ATT_PK4
            const unsigned vb = vb0 + (unsigned)(cur * VT);
            pv_one<0>(o[0], vb, pa0, pa1, pa2, pa3); pv_one<1>(o[1], vb, pa0, pa1, pa2, pa3); pv_one<2>(o[2], vb, pa0, pa1, pa2, pa3); pv_one<3>(o[3], vb, pa0, pa1, pa2, pa3);
        }
        if (j + 1 < NT) ATT_LWRITE(cur ^ 1);
        __syncthreads();
    }
    if (hi == 0) ws[32 + r32] = l_reg;
    LDS_WAIT();
    bf16* Ow = O + (size_t)(wid * 32) * ldo + r32;
#pragma unroll
    for (int r = 0; r < 16; ++r) { const int orow = crow(r, hi); const float rl = 1.0f / ws[32 + orow];
#pragma unroll
        for (int d = 0; d < 4; ++d) Ow[(size_t)orow * ldo + d * 32] = (bf16)(cvtpk(o[d][r] * rl, 0.f) & 0xffffu); }
#undef ATT_GLOAD
#undef ATT_LWRITE
}
}

__constant__ float INV_FREQ[32] = {
    1.0f, 0.74989420933245582f, 0.56234132519034908f, 0.42169650342858224f, 0.31622776601683794f, 0.23713737056616552f, 0.17782794100389228f, 0.13335214321633240f,
    0.1f, 0.074989420933245582f, 0.056234132519034908f, 0.042169650342858224f, 0.031622776601683794f, 0.023713737056616552f, 0.017782794100389228f, 0.013335214321633240f,
    0.01f, 0.0074989420933245582f, 0.0056234132519034908f, 0.0042169650342858224f, 0.0031622776601683794f, 0.0023713737056616552f, 0.0017782794100389228f, 0.0013335214321633240f,
    0.001f, 0.00074989420933245582f, 0.00056234132519034908f, 0.00042169650342858224f, 0.00031622776601683794f, 0.00023713737056616552f, 0.00017782794100389228f, 0.00013335214321633240f };

__device__ __forceinline__ void sincos_f64(float ang, float& c_out, float& s_out) {
    const double TWO_PI = 6.283185307179586476925286766559, INV_TWO_PI = 0.15915494309189533576888376337251;
    const double a = (double)ang; const double k = __builtin_rint(a * INV_TWO_PI); double r = (a - k * TWO_PI) * 0.125;
    const double r2 = r * r;
    double s = 1.0 / 6227020800.0; s = s * r2 * -1.0 + 1.0 / 39916800.0; s = -s * r2 + 1.0 / 362880.0; s = -s * r2 + 1.0 / 5040.0; s = -s * r2 + 1.0 / 120.0; s = -s * r2 + 1.0 / 6.0; s = -s * r2 + 1.0; s = s * r;
    double c = 1.0 / 479001600.0; c = -c * r2 + 1.0 / 3628800.0; c = -c * r2 + 1.0 / 40320.0; c = -c * r2 + 1.0 / 720.0; c = -c * r2 + 1.0 / 24.0; c = -c * r2 + 0.5; c = -c * r2 + 1.0;
#pragma unroll
    for (int i = 0; i < 3; ++i) { const double s2 = 2.0 * s * c, c2 = 1.0 - 2.0 * s * s; s = s2; c = c2; }
    c_out = (float)c; s_out = (float)s;
}

__device__ __forceinline__ void tr_item(const float* W, int ldw, int k0, int n0, bf16* WT, int ldt, int drow, int dmul,
                                        const float* sk, int smask, float cs, LAS float* scr, int lane) {
#pragma unroll 8
    for (int i = 0; i < 32; ++i) { const int kk = 2 * i + (lane >> 5); const float s = sk ? cs * sk[(k0 + kk) & smask] : cs;
        scr[kk * 33 + (lane & 31)] = W[(size_t)(k0 + kk) * ldw + n0 + (lane & 31)] * s; }
    LDS_WAIT(); asm volatile("" ::: "memory");
    const int c = lane & 7;
#pragma unroll
    for (int j = 0; j < 4; ++j) { const int n = (lane >> 3) + 8 * j; const LAS float* s = scr + (8 * c) * 33 + n;
        u32x4 o; o.x = cvtpk(s[0 * 33], s[1 * 33]); o.y = cvtpk(s[2 * 33], s[3 * 33]); o.z = cvtpk(s[4 * 33], s[5 * 33]); o.w = cvtpk(s[6 * 33], s[7 * 33]);
        *(u32x4*)(WT + (size_t)(drow + n * dmul) * ldt + k0 + 8 * c) = o; }
    LDS_WAIT(); asm volatile("" ::: "memory");
}
__device__ __forceinline__ float lambda_init_of(int layer) { return layer == 0 ? 0.2f : 0.35550906759199463f; }

struct Args { const float* in[19]; float* out; unsigned char* ws; int ph_lo, ph_hi; };

__device__ __forceinline__ void phase_prologue(const Args& a, LAS unsigned char* lds, int gw, int NGW, int wave, int lane) {
    LAS float* scr = (LAS float*)(lds + wave * 8448);
    unsigned char* ws = a.ws;
    constexpr int I_QKV = 16 * 96, I_WO = 16 * 32, I_QA = 16 * 12, I_KVA = 16 * 10, I_QB = 6 * 48, I_KVB = 4 * 64;
    constexpr int NITEMS = 2 * I_QKV + 2 * I_WO + 2 * I_QA + I_KVA + 2 * I_QB + I_KVB + 2 * I_WO;
    for (int it = gw; it < NITEMS; it += NGW) {
        int r = it;
        if (r < 2 * I_QKV) { const int L = r / I_QKV; r -= L * I_QKV; const int kb = r / 96, nb = r % 96;
            tr_item(a.in[1] + (size_t)L * 1024 * 3072, 3072, kb * 64, nb * 32, (bf16*)(ws + WS_WQKV) + (size_t)L * 3072 * 1024, 1024, nb * 32, 1, nullptr, 0, nb < 32 ? 0.125f * LOG2E : 1.0f, scr, lane); continue; }
        r -= 2 * I_QKV;
        if (r < 2 * I_WO) { const int L = r / I_WO; r -= L * I_WO; const int kb = r / 32, nb = r % 32;
            tr_item(a.in[4] + (size_t)L * 1024 * 1024, 1024, kb * 64, nb * 32, (bf16*)(ws + WS_WO) + (size_t)L * 1024 * 1024, 1024, nb * 32, 1, a.in[3] + L * 128, 127, 1.0f - lambda_init_of(L), scr, lane); continue; }
        r -= 2 * I_WO;
        if (r < 2 * I_QA) { const int j = r / I_QA; r -= j * I_QA; const int kb = r / 12, nb = r % 12;
            tr_item(a.in[8] + (size_t)j * 1024 * 384, 384, kb * 64, nb * 32, (bf16*)(ws + (j ? WS_WA1 : WS_WA0)), 1024, nb * 32, 1, nullptr, 0, 1.0f, scr, lane); continue; }
        r -= 2 * I_QA;
        if (r < I_KVA) { const int kb = r / 10, nb = r % 10;
            if (nb < 8) tr_item(a.in[5], 320, kb * 64, nb * 32, (bf16*)(ws + WS_WA0), 1024, 512 + nb * 32, 1, nullptr, 0, 1.0f, scr, lane);
            else        tr_item(a.in[5], 320, kb * 64, nb * 32, (bf16*)(ws + WS_WA0), 1024, 768 + (nb - 8), 2, nullptr, 0, 1.0f, scr, lane);
            continue; }
        r -= I_KVA;
        if (r < 2 * I_QB) { const int j = r / I_QB; r -= j * I_QB; const int kb = r / 48, nb = r % 48;
            const int n0 = nb * 32, head = n0 / 192, within = n0 - head * 192;
            const int drow = within < 128 ? n0 : head * 192 + 128 + ((within - 128) >> 5), dmul = within < 128 ? 1 : 2;
            tr_item(a.in[10] + (size_t)j * 384 * 1536, 1536, kb * 64, n0, (bf16*)(ws + WS_WQB + j * WQB_STRIDE), 384, drow, dmul, a.in[9] + j * 384, 511, 1.0f, scr, lane); continue; }
        r -= 2 * I_QB;
        if (r < I_KVB) { const int kb = r / 64, nb = r % 64;
            tr_item(a.in[7], 2048, kb * 64, nb * 32, (bf16*)(ws + WS_WKVB), 256, nb * 32, 1, a.in[6], 255, 1.0f, scr, lane); continue; }
        r -= I_KVB;
        { const int j = r / I_WO; r -= j * I_WO; const int kb = r / 32, nb = r % 32;
          tr_item(a.in[11] + (size_t)j * 1024 * 1024, 1024, kb * 64, nb * 32, (bf16*)(ws + WS_WMO) + (size_t)j * 1024 * 1024, 1024, nb * 32, 1, nullptr, 0, 1.0f, scr, lane); }
    }
    bf16* x16 = (bf16*)(ws + WS_X16);
    for (int m = gw; m < T; m += NGW) { const f32x4* xr = (const f32x4*)(a.in[0] + (size_t)m * D) + lane; u32x2* o8 = (u32x2*)(x16 + (size_t)m * D) + lane;
#pragma unroll
        for (int j = 0; j < 4; ++j) { const f32x4 v = xr[64 * j]; u32x2 w; w.x = cvtpk(v[0], v[1]); w.y = cvtpk(v[2], v[3]); o8[64 * j] = w; } }
    float* cosT = (float*)(ws + WS_COS); float* sinT = (float*)(ws + WS_SIN);
    for (int idx = gw * 64 + lane; idx < SEQ * 32; idx += NGW * 64) { const int pos = idx >> 5, i = idx & 31; const float ang = (float)pos * INV_FREQ[i]; float c, s; sincos_f64(ang, c, s); cosT[idx] = c; sinT[idx] = s; }
}
__device__ __forceinline__ void phase_moe_weights(const Args& a, int layer, LAS unsigned char* lds, int gw, int NGW, int wave, int lane) {
    LAS float* scr = (LAS float*)(lds + wave * 8448);
    bf16* gu = (bf16*)(a.ws + WS_MOEGU); bf16* dn = (bf16*)(a.ws + WS_MOED);
    const float* wg = a.in[14] + (size_t)layer * NE * 1024 * 256; const float* wu = a.in[15] + (size_t)layer * NE * 1024 * 256; const float* wd = a.in[16] + (size_t)layer * NE * 256 * 1024;
    for (int it = gw; it < NE * 384; it += NGW) { const int e = it / 384; int r = it - e * 384;
        if (r < 256) { const int up = r >> 7; r &= 127; const int kb = r >> 3, nb = r & 7;
            tr_item((up ? wu : wg) + (size_t)e * 1024 * 256, 256, kb * 64, nb * 32, gu, 1024, e * 512 + (nb >> 2) * 256 + up * 128 + (nb & 3) * 32, 1, nullptr, 0, 1.0f, scr, lane); }
        else { r -= 256; const int kb = r >> 5, nb = r & 31;
            tr_item(wd + (size_t)e * 256 * 1024, 1024, kb * 64, nb * 32, dn, 256, e * 1024 + nb * 32, 1, nullptr, 0, 1.0f, scr, lane); } }
}
__device__ __forceinline__ void phase_combine(const bf16* oc, bf16* o, const float* lam, float lambda_init, int gw, int NGW, int lane) {
    const float s1 = wave_sum(lam[lane] * lam[64 + lane]), s2 = wave_sum(lam[128 + lane] * lam[192 + lane]);
    const float lamf = expf(s1) - expf(s2) + lambda_init;
    for (int row = gw; row < T; row += NGW) {
#pragma unroll
        for (int i = 0; i < 2; ++i) { const int c = lane + 64 * i, head = c >> 4, off = (c & 15) * 8;
            const u32x4 a = *(const u32x4*)(oc + (size_t)row * 2048 + (2 * head) * 128 + off), b = *(const u32x4*)(oc + (size_t)row * 2048 + (2 * head + 1) * 128 + off);
            float d[8];
#pragma unroll
            for (int k = 0; k < 4; ++k) { d[2 * k] = bf_lo(a[k]) - lamf * bf_lo(b[k]); d[2 * k + 1] = bf_hi(a[k]) - lamf * bf_hi(b[k]); }
            float ss = 0.f;
#pragma unroll
            for (int k = 0; k < 8; ++k) ss += d[k] * d[k];
            ss += __shfl_xor(ss, 1); ss += __shfl_xor(ss, 2); ss += __shfl_xor(ss, 4); ss += __shfl_xor(ss, 8);
            const float r = 1.0f / sqrtf(ss * (1.0f / 128.0f) + LN_EPS);
            u32x4 w; w.x = cvtpk(d[0] * r, d[1] * r); w.y = cvtpk(d[2] * r, d[3] * r); w.z = cvtpk(d[4] * r, d[5] * r); w.w = cvtpk(d[6] * r, d[7] * r);
            *(u32x4*)(o + (size_t)row * D + head * 128 + off) = w; }
    }
}
__device__ __forceinline__ void top2_of4(float a0, float a1, float a2, float a3, int& i0, int& i1, float& v0, float& v1) {
    i0 = 0; v0 = a0; if (a1 > v0) { v0 = a1; i0 = 1; } if (a2 > v0) { v0 = a2; i0 = 2; } if (a3 > v0) { v0 = a3; i0 = 3; }
    v1 = -3.0e38f; i1 = 0;
    if (i0 != 0 && a0 > v1) { v1 = a0; i1 = 0; } if (i0 != 1 && a1 > v1) { v1 = a1; i1 = 1; } if (i0 != 2 && a2 > v1) { v1 = a2; i1 = 2; } if (i0 != 3 && a3 > v1) { v1 = a3; i1 = 3; }
}
__device__ __forceinline__ void phase_ln_router(float* x32, bf16* x16, const float* g, const float* b, const float* router_w, const float* router_b,
                                                int* tk_e, int* tk_rank, float* tk_gate, int* wgcnt, LAS unsigned char* lds, int tid, int wave, int lane, int bid) {
    LAS float* wt = (LAS float*)lds;
    LAS int* cnt = (LAS int*)(lds + MISC_OFF + 64);
    for (int idx = tid; idx < 32768; idx += NTHREADS) wt[(idx & 31) * 1028 + (idx >> 5)] = router_w[idx];
    if (tid < 32) cnt[tid] = 0;
    __syncthreads();
    f32x4 gl[4], bl[4];
#pragma unroll
    for (int j = 0; j < 4; ++j) { gl[j] = *((const f32x4*)g + lane + 64 * j); bl[j] = *((const f32x4*)b + lane + 64 * j); }
    const float rb = router_b[lane >> 1];
    for (int rr = wave; rr < RPW; rr += NWAVES) {
        const int row = bid * RPW + rr;
        f32x4* xr = (f32x4*)(x32 + (size_t)row * D) + lane;
        f32x4 v[4]; float s = 0.f;
#pragma unroll
        for (int j = 0; j < 4; ++j) { v[j] = xr[64 * j]; s += (v[j][0] + v[j][1]) + (v[j][2] + v[j][3]); }
        const float mean = wave_sum(s) * (1.f / D); float s2 = 0.f;
#pragma unroll
        for (int j = 0; j < 4; ++j) { v[j] = v[j] - mean; s2 += (v[j][0] * v[j][0] + v[j][1] * v[j][1]) + (v[j][2] * v[j][2] + v[j][3] * v[j][3]); }
        const float rstd = 1.f / sqrtf(wave_sum(s2) * (1.f / D) + LN_EPS);
        u32x2* o8 = (u32x2*)(x16 + (size_t)row * D) + lane;
#pragma unroll
        for (int j = 0; j < 4; ++j) { v[j] = v[j] * rstd * gl[j] + bl[j]; xr[64 * j] = v[j]; u32x2 w; w.x = cvtpk(v[j][0], v[j][1]); w.y = cvtpk(v[j][2], v[j][3]); o8[64 * j] = w; }
        float acc[32];
#pragma unroll
        for (int e = 0; e < 32; ++e) { float t = 0.f;
#pragma unroll
            for (int j = 0; j < 4; ++j) { const f32x4 w = *(const LAS f32x4*)(wt + e * 1028 + 4 * lane + 256 * j); t += (v[j][0] * w[0] + v[j][1] * w[1]) + (v[j][2] * w[2] + v[j][3] * w[3]); }
            acc[e] = t; }
#define RS_STAGE(M, C) _Pragma("unroll") for (int i = 0; i < C; ++i) { const bool up = (lane & M) != 0; const float send = up ? acc[i] : acc[i + C], keep = up ? acc[i + C] : acc[i]; acc[i] = keep + __shfl_xor(send, M); }
        RS_STAGE(32, 16) RS_STAGE(16, 8) RS_STAGE(8, 4) RS_STAGE(4, 2) RS_STAGE(2, 1)
#undef RS_STAGE
        const float logit = acc[0] + __shfl_xor(acc[0], 1);
        const float score = 1.0f / (1.0f + expf(-logit)), sel = score + rb;
        const int gb = lane & ~7;
        float gs; { int i0, i1; float v0, v1; top2_of4(__shfl(sel, gb), __shfl(sel, gb + 2), __shfl(sel, gb + 4), __shfl(sel, gb + 6), i0, i1, v0, v1); gs = v0 + v1; }
        int gi = lane >> 3;
#pragma unroll
        for (int M = 8; M < 64; M <<= 1) { const float os = __shfl_xor(gs, M); const int oi = __shfl_xor(gi, M); if (os > gs || (os == gs && oi < gi)) { gs = os; gi = oi; } }
        const float a0 = __shfl(sel, 8 * gi), a1 = __shfl(sel, 8 * gi + 2), a2 = __shfl(sel, 8 * gi + 4), a3 = __shfl(sel, 8 * gi + 6);
        const float c0 = __shfl(score, 8 * gi), c1 = __shfl(score, 8 * gi + 2), c2 = __shfl(score, 8 * gi + 4), c3 = __shfl(score, 8 * gi + 6);
        int i0, i1; float v0, v1; top2_of4(a0, a1, a2, a3, i0, i1, v0, v1);
        const float g0 = i0 == 0 ? c0 : i0 == 1 ? c1 : i0 == 2 ? c2 : c3, g1 = i1 == 0 ? c0 : i1 == 1 ? c1 : i1 == 2 ? c2 : c3;
        if (lane == 0) { const int e0 = 4 * gi + i0, e1 = 4 * gi + i1; const float inv = 1.0f / (g0 + g1);
            const int r0 = __hip_atomic_fetch_add(cnt + e0, 1, __ATOMIC_RELAXED, __HIP_MEMORY_SCOPE_WORKGROUP), r1 = __hip_atomic_fetch_add(cnt + e1, 1, __ATOMIC_RELAXED, __HIP_MEMORY_SCOPE_WORKGROUP);
            tk_e[2 * row] = e0; tk_e[2 * row + 1] = e1; tk_rank[2 * row] = r0; tk_rank[2 * row + 1] = r1; tk_gate[2 * row] = g0 * inv; tk_gate[2 * row + 1] = g1 * inv; }
    }
    __syncthreads();
    if (tid < 32) wgcnt[bid * 32 + tid] = cnt[tid];
}
__device__ __forceinline__ void phase_gather(const int* wgcnt, const int* tk_e, const int* tk_rank, const float* tk_gate, const bf16* x16, bf16* xs, int* tok_slot, float* slot_gate, int* panel_e,
                                             LAS unsigned char* lds, int tid, int wave, int lane, int bid, int G) {
    LAS int* ptot = (LAS int*)lds; LAS int* poff = ptot + 512; LAS int* ebase = poff + 512;
    const int my = bid, e = tid & 31, seg = tid >> 5, per = (G + 15) / 16;
    int tot = 0, off = 0;
    for (int w = seg * per; w < (seg + 1) * per && w < G; ++w) { const int c = wgcnt[w * 32 + e]; tot += c; off += (w < my) ? c : 0; }
    ptot[seg * 32 + e] = tot; poff[seg * 32 + e] = off;
    __syncthreads();
    if (wave == 0) {
        int n = 0, o = 0;
        if (lane < 32) { for (int s = 0; s < 16; ++s) { n += ptot[s * 32 + lane]; o += poff[s * 32 + lane]; } }
        const int np = (lane < 32) ? (n + 255) >> 8 : 0;
        int incl = np;
#pragma unroll
        for (int d = 1; d < 32; d <<= 1) { const int t = __shfl_up(incl, d); if (lane >= d) incl += t; }
        const int excl = incl - np;
        if (lane < 32) ebase[lane] = excl * 256 + o;
        if (my == 0) { if (lane < 32) for (int p = 0; p < np; ++p) panel_e[excl + p] = lane; if (lane == 31) panel_e[MAXPANELS] = incl; }
    }
    __syncthreads();
    for (int pi = wave; pi < 2 * RPW; pi += NWAVES) { const int idx = my * RPW * 2 + pi, token = idx >> 1;
        const int slot = ebase[tk_e[idx]] + tk_rank[idx];
        const u32x4* src = (const u32x4*)(x16 + (size_t)token * D) + lane; u32x4* dst = (u32x4*)(xs + (size_t)slot * D) + lane;
        dst[0] = src[0]; dst[64] = src[64];
        if (lane == 0) { tok_slot[idx] = slot; slot_gate[slot] = tk_gate[idx]; } }
}
__device__ __forceinline__ void phase_ln_moe(float* x32, bf16* x16, const bf16* y, const int* tok_slot, const float* g, const float* b, int gw, int NGW, int lane) {
    f32x4 gl[4], bl[4];
#pragma unroll
    for (int j = 0; j < 4; ++j) { gl[j] = *((const f32x4*)g + lane + 64 * j); bl[j] = *((const f32x4*)b + lane + 64 * j); }
    for (int row = gw; row < T; row += NGW) {
        const int s0 = tok_slot[2 * row], s1 = tok_slot[2 * row + 1];
        f32x4* xr = (f32x4*)(x32 + (size_t)row * D) + lane; const u32x2* y0 = (const u32x2*)(y + (size_t)s0 * D) + lane; const u32x2* y1 = (const u32x2*)(y + (size_t)s1 * D) + lane;
        f32x4 v[4]; float s = 0.f;
#pragma unroll
        for (int j = 0; j < 4; ++j) { const f32x4 x = xr[64 * j]; const u32x2 a = y0[64 * j], c = y1[64 * j];
            v[j][0] = x[0] * ALPHA + (bf_lo(a.x) + bf_lo(c.x)); v[j][1] = x[1] * ALPHA + (bf_hi(a.x) + bf_hi(c.x)); v[j][2] = x[2] * ALPHA + (bf_lo(a.y) + bf_lo(c.y)); v[j][3] = x[3] * ALPHA + (bf_hi(a.y) + bf_hi(c.y));
            s += (v[j][0] + v[j][1]) + (v[j][2] + v[j][3]); }
        const float mean = wave_sum(s) * (1.f / D); float s2 = 0.f;
#pragma unroll
        for (int j = 0; j < 4; ++j) { v[j] = v[j] - mean; s2 += (v[j][0] * v[j][0] + v[j][1] * v[j][1]) + (v[j][2] * v[j][2] + v[j][3] * v[j][3]); }
        const float rstd = 1.f / sqrtf(wave_sum(s2) * (1.f / D) + LN_EPS);
        u32x2* o8 = (u32x2*)(x16 + (size_t)row * D) + lane;
#pragma unroll
        for (int j = 0; j < 4; ++j) { v[j] = v[j] * rstd * gl[j] + bl[j]; xr[64 * j] = v[j]; u32x2 w; w.x = cvtpk(v[j][0], v[j][1]); w.y = cvtpk(v[j][2], v[j][3]); o8[64 * j] = w; }
    }
}

#define CAS __attribute__((address_space(4)))
extern __shared__ __attribute__((aligned(16))) unsigned char lds_raw[];
__device__ __forceinline__ const CAS Args* kargs() { return (const CAS Args*)__builtin_amdgcn_kernarg_segment_ptr(); }
#define PH_COMMON const CAS Args* ka = kargs(); asm volatile("" : "+s"(ka)); unsigned char* ws = ka->ws; LAS unsigned char* lds = (LAS unsigned char*)lds_raw; \
    int tid = threadIdx.x; asm volatile("" : "+v"(tid)); const int lane = tid & 63, wave = __builtin_amdgcn_readfirstlane(tid >> 6); int G = gridDim.x, bid = blockIdx.x; asm volatile("" : "+s"(G), "+s"(bid)); const int gw = bid * NWAVES + wave, NGW = G * NWAVES; \
    (void)ws; (void)lds; (void)lane; (void)wave; (void)gw; (void)NGW; (void)G; (void)bid;
#define PH_FN static __device__ __forceinline__ void

__device__ __forceinline__ Args load_args(const CAS Args* ka) { Args a; for (int i = 0; i < 19; ++i) a.in[i] = ka->in[i]; a.out = ka->out; a.ws = ka->ws; a.ph_lo = ka->ph_lo; a.ph_hi = ka->ph_hi; return a; }

PH_FN ph_prologue() { PH_COMMON const Args a = load_args(ka); phase_prologue(a, lds, gw, NGW, wave, lane); phase_moe_weights(a, 0, lds, gw, NGW, wave, lane); }
PH_FN ph_moe_weights(int L_) { PH_COMMON const int L = __builtin_amdgcn_readfirstlane(L_); const Args a = load_args(ka); phase_moe_weights(a, L, lds, gw, NGW, wave, lane); }
PH_FN ph_qkv(int L_) { PH_COMMON const int L = __builtin_amdgcn_readfirstlane(L_);
    pg8::Gemm g{(const bf16*)(ws + WS_X16), (const bf16*)(ws + WS_WQKV) + (size_t)L * 3072 * 1024, T, 3072, 1024}; pg8::StaticOrder S; S.init(T, 3072, G, bid);
    EpiStore E{(bf16*)(ws + WS_RA + RA_QKV), 3072};
    pg8::gemm_phase<EpiStore, pg8::StaticOrder, true, true>(lds, g, S, E); }
PH_FN ph_attn_diff() { PH_COMMON
    const bf16* qkv = (const bf16*)(ws + WS_RA + RA_QKV); bf16* oc = (bf16*)(ws + WS_RB + RB_OC);
    for (int p = bid; p < 512; p += G) {
        const int x = p & 7, i = (p >> 3) & 31, rnd = p >> 8, combo = rnd * 32 + x * 4 + (i >> 3), s = i & 7;
        const int b = combo >> 4, vh = combo & 15, h = vh >> 1, c = vh & 1;
        const float slope2 = exp2f(-(float)(h + 1)) * LOG2E;
        const bf16* kb = qkv + (size_t)b * SEQ * 3072;
#pragma unroll 1
        for (int t = 0; t < 2; ++t) { const int qb = t ? 15 - s : s;
            att::unit<64, true>(kb + (size_t)qb * 256 * 3072 + h * 128 + c * 64, 3072, kb + 1024 + h * 128 + c * 64, 3072, nullptr, 0, kb + 2048 + h * 128, 3072,
                                oc + ((size_t)b * SEQ + qb * 256) * 2048 + vh * 128, 2048, qb, slope2, lds); }
    } }
PH_FN ph_combine(int L_) { PH_COMMON const int L = __builtin_amdgcn_readfirstlane(L_);
    phase_combine((const bf16*)(ws + WS_RB + RB_OC), (bf16*)(ws + WS_RA + RA_O_DIFF), ka->in[2] + L * 256, lambda_init_of(L), gw, NGW, lane); }
PH_FN ph_mla_a(int j_) { PH_COMMON const int j = __builtin_amdgcn_readfirstlane(j_);
    const int N = j ? 512 : 1024;
    pg8::Gemm g{(const bf16*)(ws + WS_X16), (const bf16*)(ws + (j ? WS_WA1 : WS_WA0)), T, N, 1024}; pg8::StaticOrder S; S.init(T, N, G, bid);
    EpiMlaA E{(bf16*)(ws + WS_RA + RA_QA), (bf16*)(ws + WS_RA + RA_CKV), (bf16*)(ws + WS_RB + RB_KROPE), (float*)(ws + WS_SSQQ), (float*)(ws + WS_SSQKV), (const float*)(ws + WS_COS), (const float*)(ws + WS_SIN)};
    pg8::gemm_phase<EpiMlaA, pg8::StaticOrder, true, true>(lds, g, S, E); }
PH_FN ph_mla_qb(int j_) { PH_COMMON const int j = __builtin_amdgcn_readfirstlane(j_);
    pg8::Gemm g{(const bf16*)(ws + WS_RA + RA_QA), (const bf16*)(ws + WS_WQB + j * WQB_STRIDE), T, 1536, 384}; pg8::StaticOrder S; S.init(T, 1536, G, bid);
    EpiQB E{(bf16*)(ws + WS_RA + RA_Q), (const float*)(ws + WS_SSQQ), (const float*)(ws + WS_COS), (const float*)(ws + WS_SIN), 0.07216878364870322f * LOG2E};
    pg8::gemm_phase<EpiQB, pg8::StaticOrder, true, true>(lds, g, S, E); }
PH_FN ph_mla_kvb() { PH_COMMON
    pg8::Gemm g{(const bf16*)(ws + WS_RA + RA_CKV), (const bf16*)(ws + WS_WKVB), T, 2048, 256}; pg8::StaticOrder S; S.init(T, 2048, G, bid);
    EpiKVB E{(bf16*)(ws + WS_RB + RB_KV), (const float*)(ws + WS_SSQKV)};
    pg8::gemm_phase<EpiKVB, pg8::StaticOrder, true, true>(lds, g, S, E); }
PH_FN ph_attn_mla() { PH_COMMON
    const bf16* q = (const bf16*)(ws + WS_RA + RA_Q); bf16* om = (bf16*)(ws + WS_RA + RA_O_MLA); const bf16* kv = (const bf16*)(ws + WS_RB + RB_KV); const bf16* krope = (const bf16*)(ws + WS_RB + RB_KROPE);
    for (int p = bid; p < 256; p += G) {
        const int x = p & 7, i = p >> 3, combo = x * 4 + (i >> 3), s = i & 7, b = combo >> 3, h = combo & 7;
#pragma unroll 1
        for (int t = 0; t < 2; ++t) { const int qb = t ? 15 - s : s;
            att::unit<192, false>(q + ((size_t)b * SEQ + qb * 256) * 1536 + h * 192, 1536, kv + (size_t)b * SEQ * 2048 + h * 256, 2048, krope + (size_t)b * SEQ * 64, 64,
                                  kv + (size_t)b * SEQ * 2048 + h * 256 + 128, 2048, om + ((size_t)b * SEQ + qb * 256) * 1024 + h * 128, 1024, qb, 0.f, lds); }
    } }
PH_FN ph_wo(int L_) { PH_COMMON const int L = __builtin_amdgcn_readfirstlane(L_);
    const bf16* obuf = (const bf16*)(ws + WS_RA + (L < 2 ? RA_O_DIFF : RA_O_MLA));
    const bf16* wo_t = (L < 2) ? (const bf16*)(ws + WS_WO) + (size_t)L * 1024 * 1024 : (const bf16*)(ws + WS_WMO) + (size_t)(L - 2) * 1024 * 1024;
    pg8::Gemm g{obuf, wo_t, T, 1024, 1024}; pg8::StaticOrder S; S.init(T, 1024, G, bid);
    EpiRes E{L == 0 ? ka->in[0] : (const float*)ka->out, ka->out};
    pg8::gemm_phase<EpiRes, pg8::StaticOrder, true, true>(lds, g, S, E); }
PH_FN ph_ln_router(int L_) { PH_COMMON const int L = __builtin_amdgcn_readfirstlane(L_);
    phase_ln_router(ka->out, (bf16*)(ws + WS_X16), ka->in[17] + (size_t)(L * 2) * D, ka->in[18] + (size_t)(L * 2) * D, ka->in[12], ka->in[13],
                    (int*)(ws + WS_TKE), (int*)(ws + WS_TKRANK), (float*)(ws + WS_TKGATE), (int*)(ws + WS_WGCNT), lds, tid, wave, lane, bid); }
PH_FN ph_gather() { PH_COMMON
    phase_gather((const int*)(ws + WS_WGCNT), (const int*)(ws + WS_TKE), (const int*)(ws + WS_TKRANK), (const float*)(ws + WS_TKGATE), (const bf16*)(ws + WS_X16), (bf16*)(ws + WS_RA + RA_XS),
                 (int*)(ws + WS_TOKSLOT), (float*)(ws + WS_SLOTGATE), (int*)(ws + WS_PANEL), lds, tid, wave, lane, bid, G); }
PH_FN ph_up() { PH_COMMON
    pg8::Gemm g{(const bf16*)(ws + WS_RA + RA_XS), (const bf16*)(ws + WS_MOEGU), SLOT_CAP, NE * 512, 1024}; MoeOrder S; S.init((const int*)(ws + WS_PANEL), 2, G, bid);
    EpiUp E{(bf16*)(ws + WS_RA + RA_H)};
    pg8::gemm_phase<EpiUp, MoeOrder, true, true>(lds, g, S, E); }
PH_FN ph_down() { PH_COMMON
    pg8::Gemm g{(const bf16*)(ws + WS_RA + RA_H), (const bf16*)(ws + WS_MOED), SLOT_CAP, NE * 1024, 256}; MoeOrder S; S.init((const int*)(ws + WS_PANEL), 4, G, bid);
    EpiDown E{(bf16*)(ws + WS_Y), (const float*)(ws + WS_SLOTGATE)};
    pg8::gemm_phase<EpiDown, MoeOrder, true, true>(lds, g, S, E); }
PH_FN ph_ln_moe(int L_) { PH_COMMON const int L = __builtin_amdgcn_readfirstlane(L_);
    phase_ln_moe(ka->out, (bf16*)(ws + WS_X16), (const bf16*)(ws + WS_Y), (const int*)(ws + WS_TOKSLOT), ka->in[17] + (size_t)(L * 2 + 1) * D, ka->in[18] + (size_t)(L * 2 + 1) * D, gw, NGW, lane); }

constexpr int NPH = 37;
__global__ void __launch_bounds__(NTHREADS, 2) mk_fwd(Args a) {
    LAS unsigned char* lds = (LAS unsigned char*)lds_raw;
    const int tid = threadIdx.x;
    volatile LAS unsigned* MISC = (volatile LAS unsigned*)(lds + MISC_OFF);
    if (tid < 64) MISC[tid] = 0u;
    __syncthreads();
#if MK_SINGLE
    XcdBarrier bar = xcd_barrier_post((unsigned*)(a.ws + WS_CTL) + 4096, MISC);
#define SEAM() do { if (ph + 1 < hi) xcd_barrier(bar); } while (0)
#else
#define SEAM() do { } while (0)
#endif
    const int lo = a.ph_lo, hi = a.ph_hi;
    int ph = 0;
#define IN_PHASE (ph >= lo && ph < hi)
#define NEXT_PHASE() do { if (IN_PHASE) SEAM(); ++ph; } while (0)

    if (IN_PHASE) ph_prologue();
    NEXT_PHASE();
    for (int L = 0; L < 4; ++L) {
        if (L < 2) {
            if (IN_PHASE) { if (L > 0) { ph_moe_weights(L); __syncthreads(); } ph_qkv(L); }
            NEXT_PHASE();
            if (IN_PHASE) ph_attn_diff();
            NEXT_PHASE();
            if (IN_PHASE) ph_combine(L);
            NEXT_PHASE();
        } else {
            if (IN_PHASE) { ph_moe_weights(L); __syncthreads(); ph_mla_a(L - 2); }
            NEXT_PHASE();
            if (IN_PHASE) { ph_mla_qb(L - 2); if (L == 2) ph_mla_kvb(); }
            NEXT_PHASE();
            if (IN_PHASE) ph_attn_mla();
            NEXT_PHASE();
        }
        if (IN_PHASE) ph_wo(L);            NEXT_PHASE();
        if (IN_PHASE) ph_ln_router(L);     NEXT_PHASE();
        if (IN_PHASE) ph_gather();         NEXT_PHASE();
        if (IN_PHASE) ph_up();             NEXT_PHASE();
        if (IN_PHASE) ph_down();           NEXT_PHASE();
        if (IN_PHASE) ph_ln_moe(L);        NEXT_PHASE();
    }
}

extern "C" void kernel_launch(void* const* d_in, const int* in_sizes, int n_in, void* d_out, int out_size, void* d_ws, size_t ws_size, hipStream_t stream) {
    static int ok = 0;
    if (!ok) {
        if (n_in != 19 || out_size != T * D || ws_size < WS_END) { fprintf(stderr, "kernel_launch: unexpected shapes: n_in %d out %d ws %zu (need %zu)\n", n_in, out_size, ws_size, (size_t)WS_END); return; }
        if (hipFuncSetAttribute((const void*)mk_fwd, hipFuncAttributeMaxDynamicSharedMemorySize, LDS_BYTES) != hipSuccess) { fprintf(stderr, "kernel_launch: hipFuncSetAttribute failed\n"); return; }
        ok = 1;
    }
    Args a{};
    for (int i = 0; i < 19; ++i) a.in[i] = (const float*)d_in[i];
    a.out = (float*)d_out; a.ws = (unsigned char*)d_ws;
    if (hipMemsetAsync((char*)d_ws + WS_CTL, 0, CTL_ZERO_BYTES, stream) != hipSuccess) { fprintf(stderr, "kernel_launch: memset failed\n"); return; }
#if MK_SINGLE
    a.ph_lo = 0; a.ph_hi = NPH;
    hipLaunchKernelGGL(mk_fwd, dim3(GRID), dim3(NTHREADS), LDS_BYTES, stream, a);
#else
    for (int p = 0; p < NPH; ++p) { a.ph_lo = p; a.ph_hi = p + 1; hipLaunchKernelGGL(mk_fwd, dim3(GRID), dim3(NTHREADS), LDS_BYTES, stream, a); }
#endif
    const hipError_t le = hipPeekAtLastError();
    if (le != hipSuccess) fprintf(stderr, "kernel_launch: launch failed: %s\n", hipGetErrorName(le));
}
```

```cpp
#include <hip/hip_runtime.h>
#include <cstdio>
#include <cstdint>

#ifndef MK_SINGLE
#define MK_SINGLE 1
#endif

#ifndef PROBE_DUP
#define PROBE_DUP 0
#endif

__device__ __forceinline__ int mk_lane() { int l; asm volatile("v_mbcnt_lo_u32_b32 %0, -1, 0\n\tv_mbcnt_hi_u32_b32 %0, -1, %0" : "=v"(l)); return l; }
__device__ __forceinline__ int mk_tid(int wv) { return wv * 64 + mk_lane(); }

namespace pg8 {
#define PG8_LAS __attribute__((address_space(3)))
typedef unsigned short bf16_t;
typedef short bf16x8 __attribute__((ext_vector_type(8)));
typedef float f32x4 __attribute__((ext_vector_type(4)));
typedef unsigned u32x4 __attribute__((ext_vector_type(4)));
constexpr int BM = 256, BK = 64, HALF = 128, HTB = HALF * BK * 2  , STAGE_BYTES = 8 * HTB, NXCD = 8, WGM = 8;

__host__ __device__ __forceinline__ int lds_byte(int r, int c) { const int st = (r >> 4) * 2 + (c >> 5), rr = r & 15, cc = c & 31, ob = rr * 64 + cc * 2; return st * 1024 + (ob ^ (((ob >> 9) & 1) << 5)); }
__host__ __device__ __forceinline__ void stage_rc(int b, int& R, int& C) { const int st = b / 1024, sb = b % 1024, swz = sb ^ (((sb >> 9) & 1) << 5); R = (st >> 1) * 16 + swz / 64; C = (st & 1) * 32 + (swz % 64) / 2; }
__host__ __device__ __forceinline__ int perm32(int rho) { const int n = rho >> 4, i = rho & 15; return 8 * (i >> 2) + 4 * n + (i & 3); }

struct Unit { int pm, pn; };
struct Gemm { const bf16_t* A; const bf16_t* Bt; int M, N, K; };

struct StaticOrder {
    static constexpr bool GATHER = false;
    __device__ __forceinline__ unsigned row_off(const Unit&, int) const { return 0u; }
    int nM, nN, nwg, G, c, inv;
    __host__ __device__ void init(int M, int N, int G_, int c_) { nM = M / BM; nN = N / BM; nwg = nM * nN; G = G_; c = c_; inv = (65536 + nN - 1) / nN; }
    __host__ __device__ bool next(int i, Unit& u) const {
        const int L = i * G + c; if (L >= nwg) return false;
        const int wgid = (L & (NXCD - 1)) * (nwg / NXCD) + (L / NXCD);
        const int a = wgid & (WGM - 1), b = wgid / WGM, gid = (b * inv) >> 16;
        u.pm = gid * WGM + a; u.pn = b - gid * nN; return true;
    }
    __device__ __forceinline__ void a_ready(const Unit&) const {}
    __device__ __forceinline__ void done(const Unit&) const {}
};

__device__ __forceinline__ unsigned cvt_pk_bf16(float lo, float hi) { unsigned r; asm volatile("v_cvt_pk_bf16_f32 %0, %1, %2" : "=v"(r) : "v"(lo), "v"(hi)); return r; }
typedef int i32x8 __attribute__((ext_vector_type(8)));
typedef int i32x4 __attribute__((ext_vector_type(4)));
__device__ __forceinline__ i32x8 cat8(bf16x8 a, bf16x8 b) { const i32x4 x = __builtin_bit_cast(i32x4, a), y = __builtin_bit_cast(i32x4, b); return (i32x8){x[0], x[1], x[2], x[3], y[0], y[1], y[2], y[3]}; }
template <class Epi, class Sched, bool ALIGN_EPI = false, bool SP2 = false, bool F8 = false>
__device__ __forceinline__ void gemm_phase(PG8_LAS unsigned char* lds, const Gemm g, const Sched& S, const Epi& E, int wv) {
    int tid = mk_tid(wv);
    const int wid = __builtin_amdgcn_readfirstlane(tid >> 6), lane = tid & 63, wr = wid >> 2, wc = wid & 3, fr = lane & 15, fq = lane >> 4;
    const int K = g.K, nt = K / BK;
    unsigned voffA[2], voffB[2]; int rowA[2]; unsigned colA2[2];
#pragma unroll
    for (int i = 0; i < 2; ++i) { int R, C; stage_rc(tid * 16 + i * 8192, R, C); const int Rb = Epi::PERM ? ((R & ~31) + perm32(R & 31)) : R;
        voffA[i] = (unsigned)(R * K + C) * 2u; voffB[i] = (unsigned)(Rb * K + C) * 2u; rowA[i] = R; colA2[i] = (unsigned)C * 2u; }
    static_assert(!Sched::GATHER || SP2, "gather mode is written for the SP2 loop");
    unsigned gvc[2][2] = {{0u, 0u}, {0u, 0u}}, gvn[2][2] = {{0u, 0u}, {0u, 0u}};
#define PG8_GOFFS(dst, unit) do { _Pragma("unroll") for (int _h = 0; _h < 2; ++_h) _Pragma("unroll") for (int _i = 0; _i < 2; ++_i) dst[_h][_i] = S.row_off(unit, _h * HALF + rowA[_i]) + colA2[_i]; } while (0)
#define PG8_STAGE_A(bufoff, gbase, H, ARR) do { if constexpr (Sched::GATHER) { PG8_STAGE_R(rsA, bufoff, gbase, ARR[H]); } else { PG8_STAGE_R(rsA, bufoff, (gbase) + (H) * hstep, voffA); } } while (0)
    const unsigned kstep = (unsigned)(BK * 2);
    const unsigned hstep = (unsigned)HALF * (unsigned)K * 2u;
    const unsigned tstep = 2u * hstep;
    const unsigned ldsw = (unsigned)wid * 1024u;
    const int aoff = lds_byte(wr * 64 + fr, fq * 8), boff = lds_byte(wc * 32 + fr, fq * 8);
#define PG8_SA(b, h) (((b) * 2 + (h)) * HTB)
#define PG8_SB(b, h) ((4 + (b) * 2 + (h)) * HTB)
    const __amdgpu_buffer_rsrc_t rsA = __builtin_amdgcn_make_buffer_rsrc((void*)g.A, 0, 0x7fffffff, 0x00020000), rsB = __builtin_amdgcn_make_buffer_rsrc((void*)g.Bt, 0, 0x7fffffff, 0x00020000);
#define PG8_STAGE_R(RS, bufoff, goff, voff) do { _Pragma("unroll") for (int _i = 0; _i < 2; ++_i) \
        __builtin_amdgcn_raw_ptr_buffer_load_lds(RS, (PG8_LAS unsigned*)(lds + (bufoff) + ldsw + _i * 8192), 16, (voff)[_i], (goff), 0, 0); } while (0)
#define PG8_LDA(dst, b, h) do { _Pragma("unroll") for (int m = 0; m < 4; ++m) _Pragma("unroll") for (int k = 0; k < 2; ++k) dst[m][k] = *(const PG8_LAS bf16x8*)(lds + PG8_SA(b, h) + aoff + m * 2048 + k * 1024); } while (0)
#define PG8_LDB(dst, b, h) do { _Pragma("unroll") for (int n = 0; n < 2; ++n) _Pragma("unroll") for (int k = 0; k < 2; ++k) dst[n][k] = *(const PG8_LAS bf16x8*)(lds + PG8_SB(b, h) + boff + n * 2048 + k * 1024); } while (0)
#define PG8_MMA(ai, bj, At, Bt) do { __builtin_amdgcn_s_setprio(1); _Pragma("unroll") for (int m = 0; m < 4; ++m) _Pragma("unroll") for (int n = 0; n < 2; ++n) { \
        if constexpr (F8) acc[ai][bj][m][n] = __builtin_amdgcn_mfma_scale_f32_16x16x128_f8f6f4(cat8(Bt[n][0], Bt[n][1]), cat8(At[m][0], At[m][1]), acc[ai][bj][m][n], 0, 0, 0, 0, 0, 0); \
        else { _Pragma("unroll") for (int k = 0; k < 2; ++k) acc[ai][bj][m][n] = __builtin_amdgcn_mfma_f32_16x16x32_bf16(Bt[n][k], At[m][k], acc[ai][bj][m][n], 0, 0, 0); } } __builtin_amdgcn_s_setprio(0); } while (0)
#define PG8_WAIT_V(n) asm volatile("s_waitcnt vmcnt(" #n ")" ::: "memory")
#define PG8_WAIT_L(n) asm volatile("s_waitcnt lgkmcnt(" #n ")" ::: "memory")
#define PG8_BAR __builtin_amdgcn_s_barrier()
#define PG8_SCHED __builtin_amdgcn_sched_barrier(0)
    Unit cur, nxt; int ui = 0;
    if (!S.next(0, cur)) return;
    f32x4 acc[2][2][4][2];
#pragma unroll
    for (int a = 0; a < 2; ++a)
#pragma unroll
        for (int b = 0; b < 2; ++b)
#pragma unroll
            for (int m = 0; m < 4; ++m)
#pragma unroll
                for (int n = 0; n < 2; ++n) acc[a][b][m][n] = (f32x4){0.f, 0.f, 0.f, 0.f};
    bf16x8 At[4][2], B0[2][2], B1[2][2];
    unsigned cA = Sched::GATHER ? 0u : (unsigned)cur.pm * tstep, cB = (unsigned)cur.pn * tstep;
    if constexpr (Sched::GATHER) PG8_GOFFS(gvc, cur);
    S.a_ready(cur);
    if constexpr (SP2) {
        PG8_STAGE_R(rsB, PG8_SB(0, 0), cB, voffB); PG8_STAGE_R(rsB, PG8_SB(0, 1), cB + hstep, voffB); PG8_STAGE_A(PG8_SA(0, 0), cA, 0, gvc); PG8_STAGE_A(PG8_SA(0, 1), cA, 1, gvc);
        if (wr == 1) PG8_BAR;
        PG8_WAIT_V(2); PG8_BAR;
        PG8_STAGE_R(rsB, PG8_SB(1, 0), cB + kstep, voffB); PG8_STAGE_A(PG8_SA(1, 0), cA + kstep, 0, gvc); PG8_STAGE_R(rsB, PG8_SB(1, 1), cB + hstep + kstep, voffB);
        PG8_WAIT_V(6); PG8_BAR;
    } else {
        PG8_STAGE_R(rsB, PG8_SB(0, 0), cB, voffB); PG8_STAGE_R(rsA, PG8_SA(0, 0), cA, voffA); PG8_STAGE_R(rsB, PG8_SB(0, 1), cB + hstep, voffB); PG8_STAGE_R(rsA, PG8_SA(0, 1), cA + hstep, voffA);
        if (wr == 1) PG8_BAR;
        PG8_WAIT_V(4); PG8_BAR;
        PG8_STAGE_R(rsB, PG8_SB(1, 0), cB + kstep, voffB); PG8_STAGE_R(rsA, PG8_SA(1, 0), cA + kstep, voffA); PG8_STAGE_R(rsB, PG8_SB(1, 1), cB + hstep + kstep, voffB);
        PG8_WAIT_V(6); PG8_BAR;
    }
    for (;;) {
        const bool has_next = S.next(ui + 1, nxt);
        const unsigned nA = (has_next && !Sched::GATHER) ? (unsigned)nxt.pm * tstep : cA, nB = has_next ? (unsigned)nxt.pn * tstep : cB;
        if constexpr (Sched::GATHER) { if (has_next) PG8_GOFFS(gvn, nxt); else {
#pragma unroll
            for (int _h = 0; _h < 2; ++_h)
#pragma unroll
                for (int _i = 0; _i < 2; ++_i) gvn[_h][_i] = gvc[_h][_i]; } }
#pragma unroll 1
        for (int t = 0; t < nt; t += 2) {
            const bool last = (t == nt - 2);
            const unsigned a1 = cA + (unsigned)(t + 1) * kstep;
            const unsigned a2 = last ? nA : cA + (unsigned)(t + 2) * kstep, b2 = last ? nB : cB + (unsigned)(t + 2) * kstep;
            const unsigned a3 = a2 + kstep, b3 = b2 + kstep;
            if (last && has_next) S.a_ready(nxt);
            if constexpr (SP2) {
            PG8_LDB(B0, 0, 0); PG8_LDB(B1, 0, 1); PG8_SCHED; PG8_LDA(At, 0, 0); PG8_STAGE_A(PG8_SA(1, 1), a1, 1, gvc);
            if constexpr (Sched::GATHER) { if (last) {
#pragma unroll
                for (int _h = 0; _h < 2; ++_h)
#pragma unroll
                    for (int _i = 0; _i < 2; ++_i) gvc[_h][_i] = gvn[_h][_i]; } }
            PG8_WAIT_V(8); PG8_WAIT_L(0); PG8_BAR; PG8_MMA(0, 0, At, B0); PG8_MMA(0, 1, At, B1); PG8_BAR; PG8_SCHED;
            PG8_LDA(At, 0, 1); PG8_STAGE_R(rsB, PG8_SB(0, 0), b2, voffB); PG8_STAGE_R(rsB, PG8_SB(0, 1), b2 + hstep, voffB); PG8_STAGE_A(PG8_SA(0, 0), a2, 0, gvc);
            PG8_WAIT_V(8); PG8_WAIT_L(0); PG8_BAR; PG8_MMA(1, 0, At, B0); PG8_MMA(1, 1, At, B1); PG8_BAR; PG8_SCHED;
            PG8_LDB(B0, 1, 0); PG8_LDB(B1, 1, 1); PG8_SCHED; PG8_LDA(At, 1, 0); PG8_STAGE_A(PG8_SA(0, 1), a2, 1, gvc);
            PG8_WAIT_V(8); PG8_WAIT_L(0); PG8_BAR; PG8_MMA(0, 0, At, B0); PG8_MMA(0, 1, At, B1); PG8_BAR; PG8_SCHED;
            PG8_LDA(At, 1, 1); PG8_STAGE_R(rsB, PG8_SB(1, 0), b3, voffB); PG8_STAGE_R(rsB, PG8_SB(1, 1), b3 + hstep, voffB); PG8_STAGE_A(PG8_SA(1, 0), a3, 0, gvc);
            PG8_WAIT_V(8); PG8_WAIT_L(0); PG8_BAR; PG8_MMA(1, 0, At, B0); PG8_MMA(1, 1, At, B1); PG8_BAR; PG8_SCHED;
            } else {
            PG8_LDB(B0, 0, 0); PG8_SCHED; PG8_LDA(At, 0, 0); PG8_STAGE_R(rsA, PG8_SA(1, 1), a1 + hstep, voffA);
            PG8_WAIT_L(8); PG8_BAR; PG8_WAIT_L(0); PG8_MMA(0, 0, At, B0); PG8_BAR; PG8_SCHED;
            PG8_LDB(B1, 0, 1); PG8_STAGE_R(rsB, PG8_SB(0, 0), b2, voffB);
            PG8_BAR; PG8_WAIT_L(0); PG8_MMA(0, 1, At, B1); PG8_BAR;
            PG8_LDA(At, 0, 1); PG8_STAGE_R(rsA, PG8_SA(0, 0), a2, voffA);
            PG8_BAR; PG8_WAIT_L(0); PG8_MMA(1, 0, At, B0); PG8_BAR; PG8_SCHED;
            PG8_STAGE_R(rsB, PG8_SB(0, 1), b2 + hstep, voffB);
            PG8_WAIT_V(6); PG8_BAR; PG8_MMA(1, 1, At, B1); PG8_BAR;
            PG8_LDB(B0, 1, 0); PG8_SCHED; PG8_LDA(At, 1, 0); PG8_STAGE_R(rsA, PG8_SA(0, 1), a2 + hstep, voffA);
            PG8_WAIT_L(8); PG8_BAR; PG8_WAIT_L(0); PG8_MMA(0, 0, At, B0); PG8_BAR; PG8_SCHED;
            PG8_LDB(B1, 1, 1); PG8_STAGE_R(rsB, PG8_SB(1, 0), b3, voffB);
            PG8_BAR; PG8_WAIT_L(0); PG8_MMA(0, 1, At, B1); PG8_BAR;
            PG8_LDA(At, 1, 1); PG8_STAGE_R(rsA, PG8_SA(1, 0), a3, voffA);
            PG8_BAR; PG8_WAIT_L(0); PG8_MMA(1, 0, At, B0); PG8_BAR; PG8_SCHED;
            PG8_STAGE_R(rsB, PG8_SB(1, 1), b3 + hstep, voffB);
            PG8_WAIT_V(6); PG8_BAR; PG8_MMA(1, 1, At, B1); PG8_BAR;
            }
        }
        if constexpr (ALIGN_EPI) { if (wr == 0) PG8_BAR; }
        if constexpr (!Epi::AFTER_DRAIN) { E(acc, cur, wr, wc, fr, fq); S.done(cur); }
        if (!has_next) break;
#pragma unroll
        for (int a = 0; a < 2; ++a)
#pragma unroll
            for (int b = 0; b < 2; ++b)
#pragma unroll
                for (int m = 0; m < 4; ++m)
#pragma unroll
                    for (int n = 0; n < 2; ++n) acc[a][b][m][n] = (f32x4){0.f, 0.f, 0.f, 0.f};
        cur = nxt; cA = nA; cB = nB; ++ui;
        if constexpr (Sched::GATHER) {
#pragma unroll
            for (int _h = 0; _h < 2; ++_h)
#pragma unroll
                for (int _i = 0; _i < 2; ++_i) gvc[_h][_i] = gvn[_h][_i]; }
        if constexpr (ALIGN_EPI) { if (wr == 1) PG8_BAR; }
    }
    PG8_WAIT_V(0);
    if constexpr (!ALIGN_EPI) { if (wr == 0) PG8_BAR; }
    PG8_BAR;
    if constexpr (Epi::AFTER_DRAIN) { E.fused(acc, cur, wr, wc, fr, fq, lds, wid, lane); S.done(cur); }
#undef PG8_SA
#undef PG8_GOFFS
#undef PG8_STAGE_A
#undef PG8_SB
#undef PG8_STAGE_R
#undef PG8_LDA
#undef PG8_LDB
#undef PG8_MMA
#undef PG8_WAIT_V
#undef PG8_WAIT_L
#undef PG8_BAR
#undef PG8_SCHED
}
}

#define LAS __attribute__((address_space(3)))
typedef unsigned short bf16;
typedef short bf16x8 __attribute__((ext_vector_type(8)));
typedef short s16x4 __attribute__((ext_vector_type(4)));
typedef float f32x4 __attribute__((ext_vector_type(4)));
typedef float f32x16 __attribute__((ext_vector_type(16)));
typedef float f32x2 __attribute__((ext_vector_type(2)));
typedef unsigned u32x4 __attribute__((ext_vector_type(4)));
typedef unsigned u32x2 __attribute__((ext_vector_type(2)));

constexpr int T = 16384, D = 1024, SEQ = 4096, NBATCH = 4, NE = 32, FFE = 256;
constexpr int NWAVES = 8, NTHREADS = 512, GRID = 256;
constexpr float LN_EPS = 1e-5f, ALPHA = 1.6817928305074290f;
constexpr float LOG2E = 1.4426950408889634f;
constexpr float WA_SCALE = 32.0f, WKVB_SCALE = 16.0f, WMO_SCALE = 64.0f;
constexpr float K8_SCALE = 0.25f;
#ifndef MK_MOE_F8
#define MK_MOE_F8 1
#endif
constexpr bool MOE_F8 = MK_MOE_F8 != 0;
constexpr float MOEW_SCALE = 32.0f, H_SCALE = 4.0f;
constexpr bool Y_F8 = MOE_F8;
constexpr float Y_SCALE = 16.0f;
constexpr int MOE_ES = MOE_F8 ? 1 : 2;
constexpr int SLOT_CAP = 40960, MAXPANELS = SLOT_CAP / 256;
constexpr int RPW = T / GRID;

constexpr size_t MiB = 1u << 20, KiB = 1u << 10;
constexpr size_t WS_CTL = 0, CTL_ZERO_BYTES = 64 * KiB;
constexpr size_t WS_COS = 1 * MiB, WS_SIN = WS_COS + 512 * KiB;
constexpr size_t WS_SSQQ = 2 * MiB;
constexpr size_t WS_SSQKV = WS_SSQQ + 512 * KiB;
constexpr size_t WS_TKE = 3 * MiB, WS_TKPOS = WS_TKE + 128 * KiB, WS_TKGATE = WS_TKPOS + 128 * KiB, WS_STAT = WS_TKGATE + 128 * KiB;

constexpr size_t WS_WQKV = 4 * MiB;
constexpr size_t WS_WO = 16 * MiB;
constexpr size_t WS_WA0 = 20 * MiB, WS_WA1 = 22 * MiB;
constexpr size_t WS_WQB = 23 * MiB, WQB_STRIDE = 1280 * KiB;
constexpr size_t WS_WKVB = 26 * MiB;
constexpr size_t WS_WMO = 27 * MiB;
constexpr size_t WS_MOEGU = 32 * MiB;
constexpr size_t WS_MOED = 64 * MiB;
constexpr size_t WS_X16 = 80 * MiB;
constexpr size_t WS_RA = 112 * MiB;
constexpr size_t WS_RB = 216 * MiB;
constexpr size_t WS_Y = 282 * MiB;
constexpr size_t WS_XPRE = 362 * MiB;
constexpr size_t WS_X8 = 394 * MiB;
constexpr size_t WS_K8 = 410 * MiB;
constexpr size_t WS_MOEW2 = 426 * MiB;
constexpr size_t WS_RTW = 3 * MiB + 512 * KiB;
constexpr size_t WS_LIST = 474 * MiB;
constexpr size_t WS_END = 476 * MiB;
constexpr size_t RA_QKV = 0, RA_O_DIFF = 0, RA_Q = 0, RA_O_MLA = 48 * MiB, RA_QA = 80 * MiB, RA_CKV = 92 * MiB, RA_XS = 0, RA_H = 80 * MiB;
constexpr size_t RB_OD = 0, RB_KV = 0, RB_KROPE = 64 * MiB;

constexpr int LDS_MAIN = 133120;
constexpr int MISC_OFF = LDS_MAIN;
constexpr int LDS_BYTES = LDS_MAIN + 4096;
constexpr int MO_CNT = 64, MO_WBASE = 192, MO_PBASE = 320, MO_NE = 512, MO_UTAB = 640, MO_PE = 1024, MO_PRANK = 1536, MO_PGATE = 2048;
constexpr int CW_GCOUNT = 8192;

#define LDS_WAIT() asm volatile("s_waitcnt lgkmcnt(0)" ::: "memory")
#define VM_WAIT() asm volatile("s_waitcnt vmcnt(0)" ::: "memory")
typedef __bf16 cv_bf16x2 __attribute__((ext_vector_type(2)));
typedef float cv_f32x2 __attribute__((ext_vector_type(2)));
__device__ __forceinline__ unsigned cvtpk(float lo, float hi) { const cv_f32x2 v = {lo, hi}; return __builtin_bit_cast(unsigned, __builtin_convertvector(v, cv_bf16x2)); }
__device__ __forceinline__ float bf_lo(unsigned w) { return __uint_as_float(w << 16); }
__device__ __forceinline__ float bf_hi(unsigned w) { return __uint_as_float(w & 0xffff0000u); }
__device__ __forceinline__ float shx(float v, int m, int lane) { return __int_as_float(__builtin_amdgcn_ds_bpermute((lane ^ m) << 2, __float_as_int(v))); }
__device__ __forceinline__ int shxi(int v, int m, int lane) { return __builtin_amdgcn_ds_bpermute((lane ^ m) << 2, v); }
__device__ __forceinline__ float shi(float v, int src) { return __int_as_float(__builtin_amdgcn_ds_bpermute(src << 2, __float_as_int(v))); }
template <int CTRL> __device__ __forceinline__ float dppf(float v) { return __int_as_float(__builtin_amdgcn_update_dpp(0, __float_as_int(v), CTRL, 0xf, 0xf, false)); }
template <int CTRL> __device__ __forceinline__ int dppi(int v) { return __builtin_amdgcn_update_dpp(0, v, CTRL, 0xf, 0xf, false); }
__device__ __forceinline__ float wave_sum(float v, int) {
    v += dppf<0xB1>(v); v += dppf<0x4E>(v); v += dppf<0x141>(v); v += dppf<0x140>(v);
    { auto r = __builtin_amdgcn_permlane16_swap(__float_as_uint(v), __float_as_uint(v), false, false); v = __uint_as_float(r[0]) + __uint_as_float(r[1]); }
    { auto r = __builtin_amdgcn_permlane32_swap(__float_as_uint(v), __float_as_uint(v), false, false); v = __uint_as_float(r[0]) + __uint_as_float(r[1]); }
    return v;
}

#define XB_TMO      128
#define XB_XCNT(j)  (256  + 64 * (j))
#define XB_XSUB(j)  (1280 + 64 * (j))
#define XB_XGEN(j)  (2304 + 64 * (j))
#define XB_TOP      3328
#define XB_TOPGEN   3392
#define XCD_BAR_WORDS 3456
#define XB_SPIN_CAP (1u << 18)

__device__ __forceinline__ unsigned xb_ld(unsigned* p)              { return __hip_atomic_load(p, __ATOMIC_RELAXED, __HIP_MEMORY_SCOPE_AGENT); }
__device__ __forceinline__ unsigned xb_add(unsigned* p, unsigned v) { return __hip_atomic_fetch_add(p, v, __ATOMIC_RELAXED, __HIP_MEMORY_SCOPE_AGENT); }
__device__ __forceinline__ unsigned xb_xcc_id() { return (unsigned)__builtin_amdgcn_s_getreg((3 << 11) | 20) & 0xFu; }
#define XB_SPIN(cond, bar) do { unsigned _sp = 0; while (cond) { __builtin_amdgcn_s_sleep(1); \
    if ((++_sp & 255u) == 0u) { if (xb_ld(&(bar)[XB_TMO])) break; if (_sp > XB_SPIN_CAP) { atomicAdd(&(bar)[XB_TMO], 1u); break; } } } } while (0)

struct XcdBarrier {
    unsigned* bar; unsigned x;
    volatile LAS unsigned* st;
};
__device__ __forceinline__ XcdBarrier xcd_barrier_post(unsigned* bar, volatile LAS unsigned* st, int wv) {
    XcdBarrier b; b.bar = bar; b.x = xb_xcc_id(); b.st = st;
    if (mk_tid(wv) == 0) (void)xb_add(&bar[XB_XCNT(b.x)], 1u);
    return b;
}
__device__ __forceinline__ void xcd_barrier_complete(unsigned* bar, unsigned x, unsigned& nloc, unsigned& nx) {
    const unsigned G = gridDim.x * gridDim.y * gridDim.z;
    unsigned sum, cnt, mine, sp = 0u;
    for (;;) {
        sum = 0u; cnt = 0u; mine = 0u;
#pragma unroll
        for (unsigned j = 0; j < 16; ++j) { const unsigned c = xb_ld(&bar[XB_XCNT(j)]); sum += c; cnt += (c > 0u) ? 1u : 0u; mine = (j == x) ? c : mine; }
        if (sum == G) break;
        __builtin_amdgcn_s_sleep(1);
        if ((++sp & 255u) == 0u) { if (xb_ld(&bar[XB_TMO])) break; if (sp > XB_SPIN_CAP) { atomicAdd(&bar[XB_TMO], 1u); break; } }
    }
    nloc = mine > 0u ? mine : 1u; nx = cnt > 0u ? cnt : 1u;
}
__device__ __forceinline__ void xcd_barrier(const XcdBarrier& b, int wv) {
    asm volatile("s_waitcnt vmcnt(0)" ::: "memory");
    __syncthreads();
    if (mk_tid(wv) == 0) {
        unsigned* bar = b.bar; asm volatile("" : "+s"(bar));
        __builtin_amdgcn_s_waitcnt(0);
        unsigned nloc = b.st[0], nx = b.st[1];
        if (nloc == 0u) { xcd_barrier_complete(bar, b.x, nloc, nx); b.st[0] = nloc; b.st[1] = nx; }
        const unsigned old = xb_add(&bar[XB_XSUB(b.x)], 1u);
        const unsigned gen = old / nloc;
        if (old + 1u == (gen + 1u) * nloc) {
            __builtin_amdgcn_fence(__ATOMIC_RELEASE, "agent");
            asm volatile("s_waitcnt vmcnt(0)" ::: "memory");
            const unsigned og = xb_add(&bar[XB_TOP], 1u);
            const unsigned tg = og / nx;
            if (og + 1u == (tg + 1u) * nx) xb_add(&bar[XB_TOPGEN], 1u);
            else XB_SPIN(xb_ld(&bar[XB_TOPGEN]) == tg, bar);
            __builtin_amdgcn_fence(__ATOMIC_ACQUIRE, "agent");
            xb_add(&bar[XB_XGEN(b.x)], 1u);
            asm volatile("s_waitcnt vmcnt(0)" ::: "memory");
        } else {
            XB_SPIN(xb_ld(&bar[XB_XGEN(b.x)]) == gen, bar);
            __builtin_amdgcn_fence(__ATOMIC_ACQUIRE, "agent");
            asm volatile("s_waitcnt vmcnt(0)" ::: "memory");
        }
    }
    __syncthreads();
}

typedef const f32x4 (&AccRef)[2][2][4][2];
#define EPI_LANE() const int t_ = mk_lane(); const int fr = t_ & 15, fq = (t_ >> 4) & 3

__device__ __forceinline__ void moe_table(const unsigned* gcount, LAS int* pbase, LAS int* ne, int wave, int lane) {
    if (wave == 0) {
        const int n = (lane < 32) ? (int)__hip_atomic_load(gcount + (lane & 31), __ATOMIC_RELAXED, __HIP_MEMORY_SCOPE_AGENT) : 0;
        const int np = (n + 255) >> 8; int incl = np;
#pragma unroll
        for (int d = 1; d < 32; d <<= 1) { const int t = __builtin_amdgcn_ds_bpermute(((lane - d) & 63) << 2, incl); if (lane >= d) incl += t; }
        if (lane < 32) { pbase[lane] = incl - np; ne[lane] = n; }
        if (lane == 31) pbase[32] = incl;
    }
}
constexpr int MOE_MAXU = 8;
template <int NTL> __device__ __forceinline__ void moe_units(const LAS int* pbase, LAS int* utab, int G, int c, int wave, int lane) {
    if (wave == 0) {
        const int nunits = pbase[32] * NTL; int cnt = 0;
        for (int i = 0; i < MOE_MAXU; ++i) { const int L = i * G + c; if (L >= nunits) break;
            const int pm = L / NTL, t = L % NTL;
            const int e = __builtin_popcountll(__builtin_amdgcn_ballot_w64(lane >= 1 && lane < 32 && pbase[lane & 31] <= pm));
            if (lane == 0) { utab[2 * i] = pm; utab[2 * i + 1] = e * NTL + t; } ++cnt; }
        if (lane == 0) utab[2 * MOE_MAXU] = cnt;
    }
}
template <int NTL, bool GATH> struct MoeOrd {
    static constexpr bool GATHER = GATH;
    const LAS int* pbase; const LAS int* ne; const LAS int* utab; const int* list; int nmine;
    __device__ void init(const LAS int* pb, const LAS int* n, const LAS int* ut, const int* l) { pbase = pb; ne = n; utab = ut; list = l; nmine = __builtin_amdgcn_readfirstlane(ut[2 * MOE_MAXU]); }
    __device__ __forceinline__ bool next(int i, pg8::Unit& u) const {
        if (i >= nmine) return false;
        u.pm = __builtin_amdgcn_readfirstlane(utab[2 * i]); u.pn = __builtin_amdgcn_readfirstlane(utab[2 * i + 1]); return true;
    }
    __device__ __forceinline__ unsigned row_off(const pg8::Unit& u, int r) const {
        const int e = u.pn / NTL, n = ne[e]; int idx = (u.pm - pbase[e]) * 256 + r; idx = idx < n ? idx : n - 1;
        return (unsigned)list[e * T + idx] * (unsigned)(D * MOE_ES);
    }
    __device__ __forceinline__ void a_ready(const pg8::Unit&) const {}
    __device__ __forceinline__ void done(const pg8::Unit&) const {}
};

__device__ __forceinline__ u32x4 pack8(const f32x4 v0, const f32x4 v1) { u32x4 w; w.x = cvtpk(v0[0], v0[1]); w.y = cvtpk(v0[2], v0[3]); w.z = cvtpk(v1[0], v1[1]); w.w = cvtpk(v1[2], v1[3]); return w; }
__device__ __forceinline__ float f8clamp(float v) { return __builtin_amdgcn_fmed3f(v, -448.0f, 448.0f); }
__device__ __forceinline__ u32x2 pack8_f8(const f32x4 v0, const f32x4 v1) { int a = 0, b = 0;
    a = __builtin_amdgcn_cvt_pk_fp8_f32(v0[0], v0[1], a, false); a = __builtin_amdgcn_cvt_pk_fp8_f32(v0[2], v0[3], a, true);
    b = __builtin_amdgcn_cvt_pk_fp8_f32(v1[0], v1[1], b, false); b = __builtin_amdgcn_cvt_pk_fp8_f32(v1[2], v1[3], b, true); u32x2 w; w.x = (unsigned)a; w.y = (unsigned)b; return w; }
__device__ __forceinline__ f32x4 f8clamp4(const f32x4 v) { f32x4 r; r[0] = f8clamp(v[0]); r[1] = f8clamp(v[1]); r[2] = f8clamp(v[2]); r[3] = f8clamp(v[3]); return r; }

struct EpiStore {
    static constexpr bool PERM = true, AFTER_DRAIN = false;
    bf16* O; int ldc;
    __device__ __forceinline__ void operator()(AccRef acc, const pg8::Unit& u, int wr, int wc, int, int) const {
        EPI_LANE();
        const int row0 = u.pm * 256 + wr * 64 + fr, col0 = u.pn * 256 + wc * 32 + 8 * fq;
#pragma unroll
        for (int ai = 0; ai < 2; ++ai)
#pragma unroll
            for (int m = 0; m < 4; ++m) { bf16* rowp = O + (size_t)(row0 + ai * 128 + m * 16) * ldc + col0;
#pragma unroll
                for (int bj = 0; bj < 2; ++bj) *(u32x4*)(rowp + bj * 128) = pack8(acc[ai][bj][m][0], acc[ai][bj][m][1]); }
    }
};
struct EpiRes {
    static constexpr bool PERM = true, AFTER_DRAIN = false;
    const float* res32; const bf16* res16; bf16* out; float sc;
    __device__ __forceinline__ void operator()(AccRef acc, const pg8::Unit& u, int wr, int wc, int, int) const {
        EPI_LANE();
        const int row0 = u.pm * 256 + wr * 64 + fr, col0 = u.pn * 256 + wc * 32 + 8 * fq;
#pragma unroll
        for (int ai = 0; ai < 2; ++ai) {
            f32x4 r0[4][2], r1[4][2];
#pragma unroll
            for (int m = 0; m < 4; ++m) { const size_t off = (size_t)(row0 + ai * 128 + m * 16) * D + col0;
#pragma unroll
                for (int bj = 0; bj < 2; ++bj) {
                    if (res32) { r0[m][bj] = *(const f32x4*)(res32 + off + bj * 128); r1[m][bj] = *(const f32x4*)(res32 + off + bj * 128 + 4); }
                    else { const u32x4 w = *(const u32x4*)(res16 + off + bj * 128); r0[m][bj][0] = bf_lo(w.x); r0[m][bj][1] = bf_hi(w.x); r0[m][bj][2] = bf_lo(w.y); r0[m][bj][3] = bf_hi(w.y);
                           r1[m][bj][0] = bf_lo(w.z); r1[m][bj][1] = bf_hi(w.z); r1[m][bj][2] = bf_lo(w.w); r1[m][bj][3] = bf_hi(w.w); } } }
#pragma unroll
            for (int m = 0; m < 4; ++m) { const size_t off = (size_t)(row0 + ai * 128 + m * 16) * D + col0;
#pragma unroll
                for (int bj = 0; bj < 2; ++bj) *(u32x4*)(out + off + bj * 128) = pack8(r0[m][bj] * ALPHA + acc[ai][bj][m][0] * sc, r1[m][bj] * ALPHA + acc[ai][bj][m][1] * sc); }
            asm volatile("" ::: "memory"); }
    }
};
__device__ __forceinline__ void rope8(f32x4& v0, f32x4& v1, const f32x4 c, const f32x4 s) {
    float a, b;
    a = v0[0]; b = v0[1]; v0[0] = a * c[0] - b * s[0]; v0[1] = b * c[0] + a * s[0];
    a = v0[2]; b = v0[3]; v0[2] = a * c[1] - b * s[1]; v0[3] = b * c[1] + a * s[1];
    a = v1[0]; b = v1[1]; v1[0] = a * c[2] - b * s[2]; v1[1] = b * c[2] + a * s[2];
    a = v1[2]; b = v1[3]; v1[2] = a * c[3] - b * s[3]; v1[3] = b * c[3] + a * s[3];
}
struct EpiMlaA {
    static constexpr bool PERM = true, AFTER_DRAIN = false;
    bf16* qa; unsigned char* ckv8; bf16* krope; float* ssq_q; float* ssq_kv; const float* cosT; const float* sinT; float sc;
    __device__ __forceinline__ void operator()(AccRef acc, const pg8::Unit& u, int wr, int wc, int, int) const {
        EPI_LANE();
        const int row0 = u.pm * 256 + wr * 64 + fr, c8 = wc * 32 + 8 * fq;
        if (u.pn <= 2) {
            const int cbase = (u.pn == 1) ? 256 : 0, nbj = (u.pn == 1) ? 1 : 2;
            float* sp = (u.pn == 2) ? ssq_kv : ssq_q; const int sstr = (u.pn == 2) ? 4 : 8, sidx = (u.pn == 1) ? 4 + wc : wc;
#pragma unroll
            for (int ai = 0; ai < 2; ++ai)
#pragma unroll
                for (int m = 0; m < 4; ++m) { const int row = row0 + ai * 128 + m * 16; float s = 0.f;
#pragma unroll
                    for (int bj = 0; bj < 2; ++bj) if (bj < nbj) { const f32x4 v0 = acc[ai][bj][m][0] * sc, v1 = acc[ai][bj][m][1] * sc;
                        s += (v0[0] * v0[0] + v0[1] * v0[1]) + (v0[2] * v0[2] + v0[3] * v0[3]) + (v1[0] * v1[0] + v1[1] * v1[1]) + (v1[2] * v1[2] + v1[3] * v1[3]);
                        if (u.pn == 2) *(u32x2*)(ckv8 + (size_t)row * 256 + bj * 128 + c8) = pack8_f8(v0, v1);
                        else *(u32x4*)(qa + (size_t)row * 384 + cbase + bj * 128 + c8) = pack8(v0, v1); }
                    { auto r_ = __builtin_amdgcn_permlane16_swap(__float_as_uint(s), __float_as_uint(s), false, false); s = __uint_as_float(r_[0]) + __uint_as_float(r_[1]); }
                    { auto r_ = __builtin_amdgcn_permlane32_swap(__float_as_uint(s), __float_as_uint(s), false, false); s = __uint_as_float(r_[0]) + __uint_as_float(r_[1]); }
                    if (fq == 0) sp[(size_t)row * sstr + sidx] = s; }
        } else if (wc < 2) {
#pragma unroll
            for (int ai = 0; ai < 2; ++ai)
#pragma unroll
                for (int m = 0; m < 4; ++m) { const int row = row0 + ai * 128 + m * 16, pos = row & (SEQ - 1);
                    f32x4 v0 = acc[ai][0][m][0] * sc, v1 = acc[ai][0][m][1] * sc;
                    const f32x4 c = *(const f32x4*)(cosT + pos * 32 + (c8 >> 1)), s = *(const f32x4*)(sinT + pos * 32 + (c8 >> 1));
                    rope8(v0, v1, c, s);
                    *(u32x2*)((unsigned char*)krope + (size_t)row * 64 + c8) = pack8_f8(v0 * K8_SCALE, v1 * K8_SCALE); }
        }
    }
};
struct EpiQB {
    static constexpr bool PERM = true, AFTER_DRAIN = false;
    bf16* q; const float* ssq_q; const float* cosT; const float* sinT; float qscale;
    __device__ __forceinline__ void operator()(AccRef acc, const pg8::Unit& u, int wr, int wc, int, int) const {
        EPI_LANE();
        const int row0 = u.pm * 256 + wr * 64 + fr, c8 = wc * 32 + 8 * fq;
#pragma unroll
        for (int ai = 0; ai < 2; ++ai)
#pragma unroll
            for (int m = 0; m < 4; ++m) { const int row = row0 + ai * 128 + m * 16, pos = row & (SEQ - 1);
                const f32x4 pa = *(const f32x4*)(ssq_q + (size_t)row * 8), pb = *(const f32x4*)(ssq_q + (size_t)row * 8 + 4);
                const float ss = ((pa[0] + pa[1]) + (pa[2] + pa[3])) + ((pb[0] + pb[1]) + (pb[2] + pb[3]));
                const float rs = qscale / sqrtf(ss * (1.0f / 384.0f) + LN_EPS);
#pragma unroll
                for (int bj = 0; bj < 2; ++bj) { const int col = u.pn * 256 + bj * 128 + c8, head = col / 192, within = col - head * 192;
                    f32x4 v0 = acc[ai][bj][m][0] * rs, v1 = acc[ai][bj][m][1] * rs;
                    if (within >= 128) { const int i0 = (within - 128) >> 1;
                        const f32x4 c = *(const f32x4*)(cosT + pos * 32 + i0), s = *(const f32x4*)(sinT + pos * 32 + i0); rope8(v0, v1, c, s); }
                    *(u32x2*)((unsigned char*)q + (size_t)row * 1536 + col) = pack8_f8(v0, v1); } }
    }
};
struct EpiKVB {
    static constexpr bool PERM = true, AFTER_DRAIN = false;
    bf16* kv; unsigned char* k8; const float* ssq_kv; float sc;
    __device__ __forceinline__ void operator()(AccRef acc, const pg8::Unit& u, int wr, int wc, int, int) const {
        EPI_LANE();
        const int row0 = u.pm * 256 + wr * 64 + fr, col0 = u.pn * 256 + wc * 32 + 8 * fq;
#pragma unroll
        for (int ai = 0; ai < 2; ++ai)
#pragma unroll
            for (int m = 0; m < 4; ++m) { const int row = row0 + ai * 128 + m * 16;
                const f32x4 pa = *(const f32x4*)(ssq_kv + (size_t)row * 4);
                const float rs = sc / sqrtf(((pa[0] + pa[1]) + (pa[2] + pa[3])) * (1.0f / 256.0f) + LN_EPS);
                *(u32x2*)(k8 + (size_t)row * 1024 + u.pn * 128 + wc * 32 + 8 * fq) = pack8_f8(acc[ai][0][m][0] * (rs * K8_SCALE), acc[ai][0][m][1] * (rs * K8_SCALE));
                *(u32x4*)(kv + (size_t)row * 2048 + col0 + 128) = pack8(acc[ai][1][m][0] * rs, acc[ai][1][m][1] * rs); }
    }
};
__device__ __forceinline__ float silu_mul(float g, float u) { return g * u / (1.0f + __builtin_amdgcn_exp2f(-g * LOG2E)); }
struct EpiUp {
    static constexpr bool PERM = true, AFTER_DRAIN = false;
    bf16* h; float sc;
    __device__ __forceinline__ void operator()(AccRef acc, const pg8::Unit& u, int wr, int wc, int, int) const {
        EPI_LANE();
        const int row0 = u.pm * 256 + wr * 64 + fr, col0 = (u.pn & 1) * 128 + wc * 32 + 8 * fq;
#pragma unroll
        for (int ai = 0; ai < 2; ++ai)
#pragma unroll
            for (int m = 0; m < 4; ++m) { f32x4 v0, v1;
#pragma unroll
                for (int i = 0; i < 4; ++i) { v0[i] = silu_mul(acc[ai][0][m][0][i] * sc, acc[ai][1][m][0][i] * sc); v1[i] = silu_mul(acc[ai][0][m][1][i] * sc, acc[ai][1][m][1][i] * sc); }
                if constexpr (MOE_F8) {
#pragma unroll
                    for (int i = 0; i < 4; ++i) { v0[i] = f8clamp(v0[i] * H_SCALE); v1[i] = f8clamp(v1[i] * H_SCALE); }
                    *(u32x2*)((unsigned char*)h + (size_t)(row0 + ai * 128 + m * 16) * FFE + col0) = pack8_f8(v0, v1); }
                else *(u32x4*)(h + (size_t)(row0 + ai * 128 + m * 16) * FFE + col0) = pack8(v0, v1); }
    }
};
struct EpiDown {
    static constexpr bool PERM = true, AFTER_DRAIN = false;
    bf16* y; float sc;
    __device__ __forceinline__ void operator()(AccRef acc, const pg8::Unit& u, int wr, int wc, int, int) const {
        EPI_LANE();
        const int row0 = u.pm * 256 + wr * 64 + fr, col0 = (u.pn & 3) * 256 + wc * 32 + 8 * fq;
#pragma unroll
        for (int ai = 0; ai < 2; ++ai)
#pragma unroll
            for (int m = 0; m < 4; ++m) { const int row = row0 + ai * 128 + m * 16;
#pragma unroll
                for (int bj = 0; bj < 2; ++bj) { if constexpr (Y_F8) *(u32x2*)((unsigned char*)y + (size_t)row * D + col0 + bj * 128) = pack8_f8(f8clamp4(acc[ai][bj][m][0] * sc), f8clamp4(acc[ai][bj][m][1] * sc));
                    else *(u32x4*)(y + (size_t)row * D + col0 + bj * 128) = pack8(acc[ai][bj][m][0] * sc, acc[ai][bj][m][1] * sc); }
                asm volatile("" ::: "memory"); }
    }
};

namespace att {
constexpr float O8_SCALE = 16.0f;
__device__ __forceinline__ int crow(int r, int hi) { return (r & 3) + 8 * (r >> 2) + 4 * hi; }
__device__ __forceinline__ int v_st(int k, int c) { const int kk = k; return ((kk >> 3) * 4 + (c >> 5)) * 512 + ((kk & 7) * 32 + (c & 31)) * 2; }
__device__ __forceinline__ int v_rd_base(int lane) { return ((lane & 3) << 3) | (((lane >> 2) & 3) << 6) | (((lane >> 4) & 1) << 5) | (((lane >> 5) & 1) << 8); }
constexpr int v_rd_off(int d0, int ks, int half) { return d0 * 512 + ks * 4096 + half * 2048; }
template <int OFF> __device__ __forceinline__ s16x4 tr_read(unsigned vb) {
    s16x4 r; asm volatile("ds_read_b64_tr_b16 %0, %1 offset:%2" : "=&v"(r) : "v"(vb), "i"(OFF) : "memory"); return r;
}
struct VFrag { s16x4 l0, h0, l1, h1, l2, h2, l3, h3; };
template <int D0> __device__ __forceinline__ void v_read(VFrag& f, unsigned vb) {
    f.l0 = tr_read<v_rd_off(D0, 0, 0)>(vb); f.h0 = tr_read<v_rd_off(D0, 0, 1)>(vb); f.l1 = tr_read<v_rd_off(D0, 1, 0)>(vb); f.h1 = tr_read<v_rd_off(D0, 1, 1)>(vb);
    f.l2 = tr_read<v_rd_off(D0, 2, 0)>(vb); f.h2 = tr_read<v_rd_off(D0, 2, 1)>(vb); f.l3 = tr_read<v_rd_off(D0, 3, 0)>(vb); f.h3 = tr_read<v_rd_off(D0, 3, 1)>(vb);
}
__device__ __forceinline__ void pv_mma(f32x16& od, const VFrag& f, bf16x8 pa0, bf16x8 pa1, bf16x8 pa2, bf16x8 pa3) {
#define ATT_PK(L, H) (bf16x8){L[0], L[1], L[2], L[3], H[0], H[1], H[2], H[3]}
    od = __builtin_amdgcn_mfma_f32_32x32x16_bf16(pa0, ATT_PK(f.l0, f.h0), od, 0, 0, 0);
    od = __builtin_amdgcn_mfma_f32_32x32x16_bf16(pa1, ATT_PK(f.l1, f.h1), od, 0, 0, 0);
    od = __builtin_amdgcn_mfma_f32_32x32x16_bf16(pa2, ATT_PK(f.l2, f.h2), od, 0, 0, 0);
    od = __builtin_amdgcn_mfma_f32_32x32x16_bf16(pa3, ATT_PK(f.l3, f.h3), od, 0, 0, 0);
#undef ATT_PK
}
template <int S> __device__ __forceinline__ void v_read_s(VFrag& f, unsigned vb) {
    f.l0 = tr_read<v_rd_off(0, S, 0)>(vb); f.h0 = tr_read<v_rd_off(0, S, 1)>(vb); f.l1 = tr_read<v_rd_off(1, S, 0)>(vb); f.h1 = tr_read<v_rd_off(1, S, 1)>(vb);
    f.l2 = tr_read<v_rd_off(2, S, 0)>(vb); f.h2 = tr_read<v_rd_off(2, S, 1)>(vb); f.l3 = tr_read<v_rd_off(3, S, 0)>(vb); f.h3 = tr_read<v_rd_off(3, S, 1)>(vb);
}
__device__ __forceinline__ void pv_all(f32x16 (&o)[4], unsigned vb, bf16x8 pa0, bf16x8 pa1, bf16x8 pa2, bf16x8 pa3) {
    VFrag fa, fb;
    v_read<0>(fa, vb); v_read<1>(fb, vb);
    asm volatile("s_waitcnt lgkmcnt(8)" ::: "memory"); __builtin_amdgcn_sched_barrier(0);
    pv_mma(o[0], fa, pa0, pa1, pa2, pa3); __builtin_amdgcn_sched_barrier(0);
    v_read<2>(fa, vb);
    asm volatile("s_waitcnt lgkmcnt(8)" ::: "memory"); __builtin_amdgcn_sched_barrier(0);
    pv_mma(o[1], fb, pa0, pa1, pa2, pa3); __builtin_amdgcn_sched_barrier(0);
    v_read<3>(fb, vb);
    asm volatile("s_waitcnt lgkmcnt(8)" ::: "memory"); __builtin_amdgcn_sched_barrier(0);
    pv_mma(o[2], fa, pa0, pa1, pa2, pa3); __builtin_amdgcn_sched_barrier(0);
    asm volatile("s_waitcnt lgkmcnt(0)" ::: "memory"); __builtin_amdgcn_sched_barrier(0);
    pv_mma(o[3], fb, pa0, pa1, pa2, pa3);
}
template <int DQK> __device__ __forceinline__ int k_off(int row, int c) { return row * (DQK * 2) + (((c & ~7) | ((c ^ (row >> 1)) & 7)) << 4); }

#define ATT_PK4(P, BASE, OUT) do { unsigned a0 = cvtpk(P[BASE + 0], P[BASE + 1]), a1 = cvtpk(P[BASE + 2], P[BASE + 3]);   \
    unsigned b0_ = cvtpk(P[BASE + 4], P[BASE + 5]), b1_ = cvtpk(P[BASE + 6], P[BASE + 7]);                              \
    u32x4 w = {a0, a1, b0_, b1_}; OUT = __builtin_bit_cast(bf16x8, w); } while (0)
__device__ __forceinline__ float sm_halfmax(const f32x16& p0, const f32x16& p1) {
    float pmax = p0[0];
#pragma unroll
    for (int r = 1; r < 16; ++r) pmax = __builtin_elementwise_maximum(pmax, p0[r]);
#pragma unroll
    for (int r = 0; r < 16; ++r) pmax = __builtin_elementwise_maximum(pmax, p1[r]);
    return pmax;
}
__device__ __forceinline__ float sm_fullmax(float hm) { auto rr = __builtin_amdgcn_permlane32_swap(__float_as_uint(hm), __float_as_uint(hm), false, false); return fmaxf(__uint_as_float(rr[0]), __uint_as_float(rr[1])); }
template <int DQK, bool ALIBI, bool OF8 = false, bool K8 = false>
__device__ __forceinline__ void unit3(const bf16* Q, int ldq, const bf16* K1, int ldk1, const bf16* K2, int ldk2, const bf16* V, int ldv,
                                      bf16* O, int ldo, int qb, bool rev, float slope2, int EPI, float lam, LAS unsigned char* lds, int wv) {
    static_assert(!K8 || (DQK == 192 && !ALIBI), "fp8 Q K^T is written for the latent attention");
    constexpr int NCH = DQK / 8, KPT = K8 ? 1 : NCH / 8, KT = K8 ? 64 * DQK : 64 * DQK * 2, VT = 16384, NKS = K8 ? 1 : DQK / 16, KPD = 3;
    constexpr float THR = 6.0f, OFF = -1.0e30f;
    int tid = mk_tid(wv);
    const int wid = __builtin_amdgcn_readfirstlane(tid >> 6), lane = tid & 63, r32 = lane & 31, hi = lane >> 5;
    LAS unsigned char* Kl = lds; LAS unsigned char* Vl = lds + 2 * KT; LAS float* ws = (LAS float*)(lds + 2 * KT + 3 * VT) + wid * 64;
    bf16x8 qr[NKS]; pg8::i32x8 q8[3];
    if constexpr (K8) { const unsigned char* Qb = (const unsigned char*)Q + (size_t)(wid * 32 + r32) * ldq + hi * 32;
#pragma unroll
        for (int kb = 0; kb < 3; ++kb) q8[kb] = pg8::cat8(*(const bf16x8*)(Qb + kb * 64), *(const bf16x8*)(Qb + kb * 64 + 16)); }
    else { const bf16* Qw = Q + (size_t)(wid * 32 + r32) * ldq + hi * 8;
#pragma unroll
      for (int d0 = 0; d0 < NKS; ++d0) qr[d0] = *(const bf16x8*)(Qw + d0 * 16); }
    const int sr = tid >> 4, sc = (tid & 15) * 8, vst0 = v_st(sr, sc), vst1 = v_st(32 + sr, sc);
    const unsigned voff0 = (unsigned)(sr * ldv + sc) * 2u, voff1 = (unsigned)((32 + sr) * ldv + sc) * 2u;
    constexpr int KPN = (DQK > 128) ? 2 : 1, C1 = (DQK > 128) ? 16 : 8;
    unsigned koff[KPT]; int kdst[KPT]; unsigned koff2 = 0u; int kdst2 = 0;
    if constexpr (K8) {
        const int row = tid >> 3, cc = tid & 7, sw = (row >> 2) & 3;
        koff[0] = (unsigned)(row * ldk1 + cc * 16); kdst[0] = (cc >> 2) * 4096 + row * 64 + (((cc & 3) ^ sw) << 4);
        koff2 = (unsigned)(row * ldk2 + cc * 8); kdst2 = 2 * 4096 + row * 64 + (((cc >> 1) ^ sw) << 4) + (cc & 1) * 8;
    } else {
#pragma unroll
    for (int i = 0; i < KPT; ++i) {
        if (i < KPN) { const int idx = tid + 512 * i, row = idx / C1, cc = idx % C1; koff[i] = (unsigned)(row * ldk1 + cc * 8) * 2u; kdst[i] = k_off<DQK>(row, cc); }
        else { const int row = tid >> 3, cc = tid & 7; koff[i] = (unsigned)(row * ldk2 + cc * 8) * 2u; kdst[i] = k_off<DQK>(row, 16 + cc); } } }
    bf16x8 vs0, vs1, ks[KPT]; u32x2 ks2 = {0u, 0u};
#define U3_GLOAD(j) do { const unsigned tv_ = (unsigned)(j) * (unsigned)(64 * 2) * (unsigned)ldv; vs0 = *(const bf16x8*)((const char*)V + (tv_ + voff0)); vs1 = *(const bf16x8*)((const char*)V + (tv_ + voff1)); \
    if constexpr (K8) { ks[0] = *(const bf16x8*)((const char*)K1 + ((unsigned)(j) * 64u * (unsigned)ldk1 + koff[0])); ks2 = *(const u32x2*)((const char*)K2 + ((unsigned)(j) * 64u * (unsigned)ldk2 + koff2)); } \
    else { const unsigned t1_ = (unsigned)(j) * (unsigned)(64 * 2) * (unsigned)ldk1, t2_ = (unsigned)(j) * (unsigned)(64 * 2) * (unsigned)ldk2; \
    _Pragma("unroll") for (int _i = 0; _i < KPT; ++_i) ks[_i] = *(const bf16x8*)((_i < KPN ? (const char*)K1 + (t1_ + koff[_i]) : (const char*)K2 + (t2_ + koff[_i]))); } } while (0)
#define U3_LWRITE(kb, vb) do { *(LAS bf16x8*)(Vl + (vb) * VT + vst0) = vs0; *(LAS bf16x8*)(Vl + (vb) * VT + vst1) = vs1; \
    _Pragma("unroll") for (int _i = 0; _i < KPT; ++_i) *(LAS bf16x8*)(Kl + (kb) * KT + kdst[_i]) = ks[_i]; \
    if constexpr (K8) *(LAS u32x2*)(Kl + (kb) * KT + kdst2) = ks2; } while (0)
    const unsigned vb0 = (unsigned)(size_t)Vl + (unsigned)v_rd_base(lane);
    const int swz = (r32 >> 1) & 7;
    const int kro8 = r32 * 64, kc8a = ((2 * hi) ^ ((r32 >> 2) & 3)) << 4, kc8b = ((2 * hi + 1) ^ ((r32 >> 2) & 3)) << 4;
    f32x16 o[4];
#pragma unroll
    for (int r = 0; r < 16; ++r) {
#pragma unroll
        for (int d = 0; d < 4; ++d) o[d][r] = 0.f; }
    float m_cur = 0.f, l_reg = 0.f;
    bf16x8 pa0, pa1, pa2, pa3;
    const int NT = 4 * qb + 4, jmax = 4 * qb + (wid >> 1), qpos = qb * 256 + wid * 32 + r32;
    const int jstep = rev ? -1 : 1, jfirst = rev ? NT - 1 : 0;
    const int act_lo = rev ? NT - 1 - jmax : 0; const unsigned act_span = rev ? (unsigned)(NT - act_lo) : (unsigned)(jmax + 1);
    bf16x8 kx0 = {0, 0, 0, 0, 0, 0, 0, 0}, kx1 = kx0; unsigned sw0 = 0u;
    if (ALIBI) { const unsigned one1 = 0x3F80u, k0b = cvtpk((float)r32, (float)r32), k1b = cvtpk((float)(32 + r32), (float)(32 + r32));
        const u32x4 a = {hi ? 0u : k0b, hi ? 0u : (one1 | (one1 << 16)), hi ? 0u : one1, 0u}, b = {hi ? 0u : k1b, hi ? 0u : (one1 | (one1 << 16)), hi ? 0u : one1, 0u};
        kx0 = __builtin_bit_cast(bf16x8, a); kx1 = __builtin_bit_cast(bf16x8, b);
        const unsigned sh = cvtpk(slope2, 0.f) & 0xffffu; const float sl = slope2 - __uint_as_float(sh << 16); sw0 = sh | (cvtpk(sl, 0.f) << 16); }
#define U3_QK(j, kb) do { const float bnd_ = ((j) > jmax) ? OFF : -m_cur; \
    if (ALIBI) { const float base = ((j) > jmax) ? OFF : fmaf(-slope2, (float)(qpos - 64 * (j)), -m_cur); \
          \
        const unsigned bh = cvtpk(base, 0.f) & 0xffffu; const float r1 = base - __uint_as_float(bh << 16); \
        const unsigned bm = cvtpk(r1, 0.f) << 16; \
        const u32x4 qw = {hi ? 0u : sw0, hi ? 0u : (bh | bm), 0u, 0u}; const bf16x8 qx = __builtin_bit_cast(bf16x8, qw); \
        f32x16 z; _Pragma("unroll") for (int r = 0; r < 16; ++r) z[r] = 0.f; \
        p0 = __builtin_amdgcn_mfma_f32_32x32x16_bf16(kx0, qx, z, 0, 0, 0); p1 = __builtin_amdgcn_mfma_f32_32x32x16_bf16(kx1, qx, z, 0, 0, 0); \
    } else { _Pragma("unroll") for (int r = 0; r < 16; ++r) { p0[r] = bnd_; p1[r] = bnd_; } } \
    const LAS unsigned char* Kc = Kl + (kb) * KT; \
    if constexpr (K8) { pg8::i32x8 ka0[3], ka1[3]; \
        U3_KREAD8(0); U3_KREAD8(1); \
        _Pragma("unroll") for (int b_ = 0; b_ < 3; ++b_) { if (b_ == 0) U3_KREAD8(2); __builtin_amdgcn_sched_barrier(0); \
            p0 = __builtin_amdgcn_mfma_scale_f32_32x32x64_f8f6f4(ka0[b_], q8[b_], p0, 0, 0, 0, 0, 0, 0); p1 = __builtin_amdgcn_mfma_scale_f32_32x32x64_f8f6f4(ka1[b_], q8[b_], p1, 0, 0, 0, 0, 0, 0); __builtin_amdgcn_sched_barrier(0); } \
    } else { bf16x8 kb0[NKS], kb1[NKS]; \
    _Pragma("unroll") for (int d0 = 0; d0 < KPD; ++d0) U3_KREAD(d0); \
    _Pragma("unroll") for (int d0 = 0; d0 < NKS; ++d0) { if (d0 + KPD < NKS) U3_KREAD(d0 + KPD); __builtin_amdgcn_sched_barrier(0); \
        p0 = __builtin_amdgcn_mfma_f32_32x32x16_bf16(kb0[d0], qr[d0], p0, 0, 0, 0); p1 = __builtin_amdgcn_mfma_f32_32x32x16_bf16(kb1[d0], qr[d0], p1, 0, 0, 0); __builtin_amdgcn_sched_barrier(0); } } \
    if (ALIBI && (j) == jmax) { asm volatile("; diagonal tile" ::: "memory"); const float s2 = 2.f * slope2; float dk = (float)(qpos - 64 * (j) - 4 * hi), dk1 = (float)(qpos - 64 * (j) - 4 * hi - 32); \
          \
        _Pragma("unroll") for (int r = 0; r < 16; ++r) { p0[r] = fmaf(s2, fminf(dk, 0.f), p0[r]); p1[r] = fmaf(s2, fminf(dk1, 0.f), p1[r]); \
            if ((r & 3) == 3) { dk = (dk + 4.0f) - 4.0f - 1.0f - 4.0f; dk1 = (dk1 + 4.0f) - 4.0f - 1.0f - 4.0f; } else { dk -= 1.0f; dk1 -= 1.0f; } } } \
    pmax = sm_halfmax(p0, p1); } while (0)
#define U3_KREAD8(b) do { const LAS unsigned char* kp_ = Kc + (b) * 4096 + kro8; \
    ka0[b] = pg8::cat8(*(const LAS bf16x8*)(kp_ + kc8a), *(const LAS bf16x8*)(kp_ + kc8b)); ka1[b] = pg8::cat8(*(const LAS bf16x8*)(kp_ + 2048 + kc8a), *(const LAS bf16x8*)(kp_ + 2048 + kc8b)); } while (0)
#define U3_KREAD(d0) do { const int c_ = (d0) * 2 + hi, cs_ = ((c_ & ~7) | ((c_ ^ swz) & 7)) << 4; const LAS unsigned char* kp_ = Kc + r32 * (DQK * 2) + cs_; \
    kb0[d0] = *(const LAS bf16x8*)kp_; kb1[d0] = *(const LAS bf16x8*)(kp_ + 32 * (DQK * 2)); } while (0)
#define U3_EXPADD(e) do { if ((e) < 16) { p0[(e) & 15] = __builtin_amdgcn_exp2f(p0[(e) & 15]); ps_ += p0[(e) & 15]; } else { p1[(e) & 15] = __builtin_amdgcn_exp2f(p1[(e) & 15]); ps_ += p1[(e) & 15]; } } while (0)
#define U3_PKG(g) do { if ((g) == 0) ATT_PK4(p0, 0, pa0); else if ((g) == 1) ATT_PK4(p0, 8, pa1); else if ((g) == 2) ATT_PK4(p1, 0, pa2); else ATT_PK4(p1, 8, pa3); } while (0)
#define U3_CH(k) do { U3_EXPADD(2 * (k)); U3_EXPADD(2 * (k) + 1); if (((k) & 3) == 0 && (k) > 0) U3_PKG((k) / 4 - 1); __builtin_amdgcn_sched_barrier(0); } while (0)
#define U3_PKV(L, H) (bf16x8){L[0], L[1], L[2], L[3], H[0], H[1], H[2], H[3]}
#define U3_SGRP(f, PA, s) do { \
    o[0] = __builtin_amdgcn_mfma_f32_32x32x16_bf16(PA, U3_PKV(f.l0, f.h0), o[0], 0, 0, 0); U3_CH(4 * (s) + 0); \
    o[1] = __builtin_amdgcn_mfma_f32_32x32x16_bf16(PA, U3_PKV(f.l1, f.h1), o[1], 0, 0, 0); U3_CH(4 * (s) + 1); \
    o[2] = __builtin_amdgcn_mfma_f32_32x32x16_bf16(PA, U3_PKV(f.l2, f.h2), o[2], 0, 0, 0); U3_CH(4 * (s) + 2); \
    o[3] = __builtin_amdgcn_mfma_f32_32x32x16_bf16(PA, U3_PKV(f.l3, f.h3), o[3], 0, 0, 0); \
    U3_CH(4 * (s) + 3); } while (0)
#define U3_FINISH() do { float ps_ = 0.f; _Pragma("unroll") for (int k = 0; k < 16; ++k) { U3_EXPADD(2 * k); U3_EXPADD(2 * k + 1); } \
    U3_PKG(0); U3_PKG(1); U3_PKG(2); U3_PKG(3); \
    { auto rr_ = __builtin_amdgcn_permlane32_swap(__float_as_uint(ps_), __float_as_uint(ps_), false, false); l_reg += __uint_as_float(rr_[0]) + __uint_as_float(rr_[1]); } } while (0)
#define U3_SHIFT() do { shifted = __builtin_amdgcn_ballot_w64(pmax > THR) != 0ull; \
    if (shifted) { const float d = fmaxf(sm_fullmax(pmax), 0.f); alpha = __builtin_amdgcn_exp2f(-d); m_cur += d; l_reg *= alpha; \
        _Pragma("unroll") for (int r = 0; r < 16; ++r) { p0[r] -= d; p1[r] -= d; } } } while (0)
#define U3_SYNC() do { asm volatile("s_waitcnt vmcnt(0) lgkmcnt(0)" ::: "memory"); __builtin_amdgcn_s_barrier(); asm volatile("" ::: "memory"); } while (0)

    f32x16 p0, p1; float pmax, alpha = 1.f; bool shifted;
    U3_GLOAD(jfirst); asm volatile("s_waitcnt vmcnt(0)" ::: "memory"); U3_LWRITE(0, 0); U3_SYNC();
    U3_GLOAD(jfirst + jstep);
    U3_QK(jfirst, 0); U3_SHIFT(); U3_FINISH();
    U3_LWRITE(1, 1); U3_SYNC();
    int vprev = 0, vcur = 1;
#pragma unroll 1
    for (int i = 1; i < NT; ++i) {
        const int j = jfirst + jstep * i, kcur = i & 1, vnext = (vcur == 2) ? 0 : vcur + 1;
        if (i + 1 < NT) U3_GLOAD(j + jstep);
        if ((unsigned)(i - act_lo) <= act_span) {
        U3_QK(j, kcur); U3_SHIFT();
        { const unsigned _vb = vb0 + (unsigned)(vprev * VT); float ps_ = 0.f; VFrag fa, fb;
          v_read_s<0>(fa, _vb); v_read_s<1>(fb, _vb); asm volatile("s_waitcnt lgkmcnt(8)" ::: "memory"); __builtin_amdgcn_sched_barrier(0);
          U3_SGRP(fa, pa0, 0);
          v_read_s<2>(fa, _vb); asm volatile("s_waitcnt lgkmcnt(8)" ::: "memory"); __builtin_amdgcn_sched_barrier(0);
          U3_SGRP(fb, pa1, 1);
          v_read_s<3>(fb, _vb); asm volatile("s_waitcnt lgkmcnt(8)" ::: "memory"); __builtin_amdgcn_sched_barrier(0);
          U3_SGRP(fa, pa2, 2);
          asm volatile("s_waitcnt lgkmcnt(0)" ::: "memory"); __builtin_amdgcn_sched_barrier(0);
          U3_SGRP(fb, pa3, 3);
          U3_PKG(3);
          { auto rr_ = __builtin_amdgcn_permlane32_swap(__float_as_uint(ps_), __float_as_uint(ps_), false, false); l_reg += __uint_as_float(rr_[0]) + __uint_as_float(rr_[1]); } }
        if (shifted) {
            if (hi == 0) ws[r32] = alpha;
            LDS_WAIT();
#pragma unroll
            for (int r = 0; r < 16; ++r) { const float a = ws[crow(r, hi)];
#pragma unroll
                for (int dd = 0; dd < 4; ++dd) o[dd][r] *= a; } }
        }
        if (i + 1 < NT) U3_LWRITE(kcur ^ 1, vnext);
        U3_SYNC();
        vprev = vcur; vcur = vnext;
    }
    { const unsigned _vb = vb0 + (unsigned)(vprev * VT); pv_all(o, _vb, pa0, pa1, pa2, pa3); }
    if (hi == 0) ws[32 + r32] = l_reg;
    LDS_WAIT();
    LAS unsigned* Osave = (LAS unsigned*)(lds + 2 * KT + 3 * VT + 2048);
    if (EPI == 1) {
#pragma unroll
        for (int r = 0; r < 16; ++r) { const float rl = __builtin_amdgcn_rcpf(ws[32 + crow(r, hi)]);
            Osave[(r * 2 + 0) * 512 + tid] = cvtpk(o[0][r] * rl, o[1][r] * rl); Osave[(r * 2 + 1) * 512 + tid] = cvtpk(o[2][r] * rl, o[3][r] * rl); }
    } else {
        bf16* Ow = O + (size_t)(wid * 32 + 4 * hi) * ldo + r32;
#pragma unroll
        for (int r = 0; r < 16; ++r) { const float rl = __builtin_amdgcn_rcpf(ws[32 + crow(r, hi)]); bf16* orow = Ow + (size_t)((r & 3) + 8 * (r >> 2)) * ldo;
            float v[4];
#pragma unroll
            for (int d = 0; d < 4; ++d) v[d] = o[d][r] * rl;
            if (EPI == 2) { const unsigned w0 = Osave[(r * 2 + 0) * 512 + tid], w1 = Osave[(r * 2 + 1) * 512 + tid];
                v[0] = bf_lo(w0) - lam * v[0]; v[1] = bf_hi(w0) - lam * v[1]; v[2] = bf_lo(w1) - lam * v[2]; v[3] = bf_hi(w1) - lam * v[3];
                float ss = (v[0] * v[0] + v[1] * v[1]) + (v[2] * v[2] + v[3] * v[3]);
                ss += dppf<0xB1>(ss); ss += dppf<0x4E>(ss); ss += dppf<0x141>(ss); ss += dppf<0x140>(ss);
                { auto r_ = __builtin_amdgcn_permlane16_swap(__float_as_uint(ss), __float_as_uint(ss), false, false); ss = __uint_as_float(r_[0]) + __uint_as_float(r_[1]); }
                const float rn = 1.0f / sqrtf(ss * (1.0f / 128.0f) + LN_EPS);
#pragma unroll
                for (int d = 0; d < 4; ++d) v[d] *= rn; }
            if constexpr (OF8) { unsigned char* orow8 = (unsigned char*)O + (size_t)(wid * 32 + 4 * hi + (r & 3) + 8 * (r >> 2)) * ldo + r32;
#pragma unroll
                for (int d = 0; d < 4; ++d) orow8[d * 32] = (unsigned char)(__builtin_amdgcn_cvt_pk_fp8_f32(__builtin_amdgcn_fmed3f(v[d] * O8_SCALE, -448.0f, 448.0f), 0.f, 0, false) & 0xff); }
            else {
#pragma unroll
                for (int d = 0; d < 4; ++d) orow[d * 32] = (bf16)(cvtpk(v[d], 0.f) & 0xffffu); } }
    }
    asm volatile("s_waitcnt lgkmcnt(0)" ::: "memory"); __builtin_amdgcn_s_barrier(); asm volatile("" ::: "memory");
#undef U3_GLOAD
#undef U3_LWRITE
#undef U3_QK
#undef U3_KREAD
#undef U3_KREAD8
#undef U3_EXPADD
#undef U3_PKG
#undef U3_CH
#undef U3_PKV
#undef U3_SGRP
#undef U3_FINISH
#undef U3_SHIFT
#undef U3_SYNC
}
}

__constant__ float INV_FREQ[32] = {
    1.0f, 0.74989420933245582f, 0.56234132519034908f, 0.42169650342858224f, 0.31622776601683794f, 0.23713737056616552f, 0.17782794100389228f, 0.13335214321633240f,
    0.1f, 0.074989420933245582f, 0.056234132519034908f, 0.042169650342858224f, 0.031622776601683794f, 0.023713737056616552f, 0.017782794100389228f, 0.013335214321633240f,
    0.01f, 0.0074989420933245582f, 0.0056234132519034908f, 0.0042169650342858224f, 0.0031622776601683794f, 0.0023713737056616552f, 0.0017782794100389228f, 0.0013335214321633240f,
    0.001f, 0.00074989420933245582f, 0.00056234132519034908f, 0.00042169650342858224f, 0.00031622776601683794f, 0.00023713737056616552f, 0.00017782794100389228f, 0.00013335214321633240f };

__device__ __forceinline__ void sincos_f64(float ang, float& c_out, float& s_out) {
    const double TWO_PI = 6.283185307179586476925286766559, INV_TWO_PI = 0.15915494309189533576888376337251;
    const double a = (double)ang; const double k = __builtin_rint(a * INV_TWO_PI); double r = (a - k * TWO_PI) * 0.125;
    const double r2 = r * r;
    double s = 1.0 / 6227020800.0; s = s * r2 * -1.0 + 1.0 / 39916800.0; s = -s * r2 + 1.0 / 362880.0; s = -s * r2 + 1.0 / 5040.0; s = -s * r2 + 1.0 / 120.0; s = -s * r2 + 1.0 / 6.0; s = -s * r2 + 1.0; s = s * r;
    double c = 1.0 / 479001600.0; c = -c * r2 + 1.0 / 3628800.0; c = -c * r2 + 1.0 / 40320.0; c = -c * r2 + 1.0 / 720.0; c = -c * r2 + 1.0 / 24.0; c = -c * r2 + 0.5; c = -c * r2 + 1.0;
#pragma unroll
    for (int i = 0; i < 3; ++i) { const double s2 = 2.0 * s * c, c2 = 1.0 - 2.0 * s * s; s = s2; c = c2; }
    c_out = (float)c; s_out = (float)s;
}

template <bool F8 = false>
__device__ __forceinline__ void tr_item(const float* W, int ldw, int k0, int n0, bf16* WT, int ldt, int drow, int dmul,
                                        const float* sk, int smask, float cs, LAS float* scr, int lane) {
    const int kr = lane >> 3, nc = (lane & 7) * 4;
    f32x4 v[8]; float s[8];
#pragma unroll
    for (int i = 0; i < 8; ++i) { v[i] = *(const f32x4*)(W + (size_t)(k0 + kr + 8 * i) * ldw + n0 + nc); s[i] = sk ? cs * sk[(k0 + kr + 8 * i) & smask] : cs; }
#pragma unroll
    for (int i = 0; i < 8; ++i) { LAS float* w = scr + (kr + 8 * i) * 33 + nc; w[0] = v[i][0] * s[i]; w[1] = v[i][1] * s[i]; w[2] = v[i][2] * s[i]; w[3] = v[i][3] * s[i]; }
    LDS_WAIT(); asm volatile("" ::: "memory");
    const int c = lane & 7;
#pragma unroll
    for (int j = 0; j < 4; ++j) { const int n = (lane >> 3) + 8 * j; const LAS float* sp = scr + (8 * c) * 33 + n;
        if constexpr (F8) { const f32x4 a = {sp[0 * 33], sp[1 * 33], sp[2 * 33], sp[3 * 33]}, b = {sp[4 * 33], sp[5 * 33], sp[6 * 33], sp[7 * 33]};
            *(u32x2*)((unsigned char*)WT + (size_t)(drow + n * dmul) * ldt + k0 + 8 * c) = pack8_f8(a, b); }
        else { u32x4 o; o.x = cvtpk(sp[0 * 33], sp[1 * 33]); o.y = cvtpk(sp[2 * 33], sp[3 * 33]); o.z = cvtpk(sp[4 * 33], sp[5 * 33]); o.w = cvtpk(sp[6 * 33], sp[7 * 33]);
            *(u32x4*)(WT + (size_t)(drow + n * dmul) * ldt + k0 + 8 * c) = o; } }
    LDS_WAIT(); asm volatile("" ::: "memory");
}
__device__ __forceinline__ float lambda_init_of(int layer) { return layer == 0 ? 0.2f : 0.35550906759199463f; }

struct Args { const float* in[19]; float* out; unsigned char* ws; int ph_lo, ph_hi; };

__device__ __forceinline__ void phase_prologue(const Args& a, LAS unsigned char* lds, int gw, int NGW, int wave, int lane) {
    LAS float* scr = (LAS float*)(lds + wave * 8448);
    unsigned char* ws = a.ws;
    constexpr int I_QKV = 16 * 96, I_WO = 16 * 32, I_QA = 16 * 12, I_KVA = 16 * 10, I_QB = 6 * 48, I_KVB = 4 * 64;
    constexpr int NITEMS = 2 * I_QKV + 2 * I_WO + 2 * I_QA + I_KVA + 2 * I_QB + I_KVB + 2 * I_WO;
    for (int it = gw; it < NITEMS; it += NGW) {
        int r = it;
        if (r < 2 * I_QKV) { const int L = r / I_QKV; r -= L * I_QKV; const int kb = r / 96, nb = r % 96;
            tr_item(a.in[1] + (size_t)L * 1024 * 3072, 3072, kb * 64, nb * 32, (bf16*)(ws + WS_WQKV) + (size_t)L * 3072 * 1024, 1024, nb * 32, 1, nullptr, 0, nb < 32 ? 0.125f * LOG2E : 1.0f, scr, lane); continue; }
        r -= 2 * I_QKV;
        if (r < 2 * I_WO) { const int L = r / I_WO; r -= L * I_WO; const int kb = r / 32, nb = r % 32;
            tr_item(a.in[4] + (size_t)L * 1024 * 1024, 1024, kb * 64, nb * 32, (bf16*)(ws + WS_WO) + (size_t)L * 1024 * 1024, 1024, nb * 32, 1, a.in[3] + L * 128, 127, 1.0f - lambda_init_of(L), scr, lane); continue; }
        r -= 2 * I_WO;
        if (r < 2 * I_QA) { const int j = r / I_QA; r -= j * I_QA; const int kb = r / 12, nb = r % 12;
            tr_item<true>(a.in[8] + (size_t)j * 1024 * 384, 384, kb * 64, nb * 32, (bf16*)(ws + (j ? WS_WA1 : WS_WA0)), 1024, nb * 32, 1, nullptr, 0, WA_SCALE, scr, lane); continue; }
        r -= 2 * I_QA;
        if (r < I_KVA) { const int kb = r / 10, nb = r % 10;
            if (nb < 8) tr_item<true>(a.in[5], 320, kb * 64, nb * 32, (bf16*)(ws + WS_WA0), 1024, 512 + nb * 32, 1, nullptr, 0, WA_SCALE, scr, lane);
            else        tr_item<true>(a.in[5], 320, kb * 64, nb * 32, (bf16*)(ws + WS_WA0), 1024, 768 + (nb - 8), 2, nullptr, 0, WA_SCALE, scr, lane);
            continue; }
        r -= I_KVA;
        if (r < 2 * I_QB) { const int j = r / I_QB; r -= j * I_QB; const int kb = r / 48, nb = r % 48;
            const int n0 = nb * 32, head = n0 / 192, within = n0 - head * 192;
            const int drow = within < 128 ? n0 : head * 192 + 128 + ((within - 128) >> 5), dmul = within < 128 ? 1 : 2;
            tr_item(a.in[10] + (size_t)j * 384 * 1536, 1536, kb * 64, n0, (bf16*)(ws + WS_WQB + j * WQB_STRIDE), 384, drow, dmul, a.in[9] + j * 384, 511, 1.0f, scr, lane); continue; }
        r -= 2 * I_QB;
        if (r < I_KVB) { const int kb = r / 64, nb = r % 64;
            tr_item<true>(a.in[7], 2048, kb * 64, nb * 32, (bf16*)(ws + WS_WKVB), 256, nb * 32, 1, a.in[6], 255, WKVB_SCALE, scr, lane); continue; }
        r -= I_KVB;
        { const int j = r / I_WO; r -= j * I_WO; const int kb = r / 32, nb = r % 32;
          tr_item<true>(a.in[11] + (size_t)j * 1024 * 1024, 1024, kb * 64, nb * 32, (bf16*)(ws + WS_WMO + (size_t)j * 1024 * 1024), 1024, nb * 32, 1, nullptr, 0, WMO_SCALE, scr, lane); }
    }
    bf16* x16 = (bf16*)(ws + WS_X16);
#pragma unroll 1
    for (int m = gw * (T / NGW); m < (gw + 1) * (T / NGW); m += 4) {
        f32x4 v[4][4];
#pragma unroll
        for (int q = 0; q < 4; ++q) { const f32x4* xr = (const f32x4*)(a.in[0] + (size_t)(m + q) * D) + lane;
#pragma unroll
            for (int j = 0; j < 4; ++j) v[q][j] = xr[64 * j]; }
#pragma unroll
        for (int q = 0; q < 4; ++q) { u32x2* o8 = (u32x2*)(x16 + (size_t)(m + q) * D) + lane;
#pragma unroll
            for (int j = 0; j < 4; ++j) { u32x2 w; w.x = cvtpk(v[q][j][0], v[q][j][1]); w.y = cvtpk(v[q][j][2], v[q][j][3]); o8[64 * j] = w; } } }
    { bf16* wh = (bf16*)(ws + WS_RTW); bf16* wl = wh + 32 * 1024;
      for (int idx = gw * 64 + lane; idx < 32768; idx += NGW * 64) { const int k = idx >> 5, e = idx & 31; const float w = a.in[12][idx];
          const unsigned h = cvtpk(w, 0.f) & 0xffffu; const float r = w - __uint_as_float(h << 16); wh[e * 1024 + k] = (bf16)h; wl[e * 1024 + k] = (bf16)(cvtpk(r, 0.f) & 0xffffu); } }
    float* cosT = (float*)(ws + WS_COS); float* sinT = (float*)(ws + WS_SIN);
    for (int idx = gw * 64 + lane; idx < SEQ * 32; idx += NGW * 64) { const int pos = idx >> 5, i = idx & 31; const float ang = (float)pos * INV_FREQ[i]; float c, s; sincos_f64(ang, c, s); cosT[idx] = c; sinT[idx] = s; }
}
struct TrSrc { const float* p; int ldw; };
__device__ __forceinline__ void moe_item(const float* wg, const float* wu, const float* wd, int it, int part, TrSrc& s, unsigned char*& dst, int& ldt, unsigned char* gu, unsigned char* dn) {
    int e, r; if (part == 0) { e = it >> 8; r = it & 255; } else if (part == 1) { e = it >> 7; r = 256 + (it & 127); } else { e = it / 384; r = it - e * 384; }
    if (r < 256) { const int up = r >> 7; r &= 127; const int kb = r >> 3, nb = r & 7;
        s.p = (up ? wu : wg) + (size_t)e * 1024 * 256 + (size_t)(kb * 64) * 256 + nb * 32; s.ldw = 256;
        dst = gu + ((size_t)(e * 512 + (nb >> 2) * 256 + up * 128 + (nb & 3) * 32) * 1024 + kb * 64) * MOE_ES; ldt = 1024; }
    else { r -= 256; const int kb = r >> 5, nb = r & 31;
        s.p = wd + (size_t)e * 256 * 1024 + (size_t)(kb * 64) * 1024 + nb * 32; s.ldw = 1024;
        dst = dn + ((size_t)(e * 1024 + nb * 32) * 256 + kb * 64) * MOE_ES; ldt = 256; }
}
__device__ __forceinline__ void phase_moe_weights(const Args& a, int layer, int part, LAS unsigned char* lds, int gw, int NGW, int wave, int lane, int it_lo = 0, int it_hi = 1 << 30) {
    LAS float* scr = (LAS float*)(lds + wave * 8448);
    unsigned char* gu = a.ws + ((layer & 1) ? WS_MOEW2 : WS_MOEGU); unsigned char* dn = a.ws + ((layer & 1) ? WS_MOEW2 + 32 * MiB : WS_MOED);
    const float* wg = a.in[14] + (size_t)layer * NE * 1024 * 256; const float* wu = a.in[15] + (size_t)layer * NE * 1024 * 256; const float* wd = a.in[16] + (size_t)layer * NE * 256 * 1024;
    const int kr = lane >> 3, nc = (lane & 7) * 4;
    constexpr int NPF = 3;
    f32x4 buf[NPF][8]; unsigned char* bdst[NPF]; int bldt[NPF];
    const int nall = (part == 0) ? NE * 256 : (part == 1) ? NE * 128 : NE * 384, nitems = it_hi < nall ? it_hi : nall;
    const int it0 = it_lo + gw;
#pragma unroll
    for (int q = 0; q < NPF; ++q) { bdst[q] = nullptr; bldt[q] = 0; const int iq = it0 + q * NGW;
        if (iq < nitems) { TrSrc s; moe_item(wg, wu, wd, iq, part, s, bdst[q], bldt[q], gu, dn);
#pragma unroll
            for (int i = 0; i < 8; ++i) buf[q][i] = *(const f32x4*)(s.p + (size_t)(kr + 8 * i) * s.ldw + nc); } }
#pragma unroll 1
    for (int it = it0; it < nitems; it += NPF * NGW) {
#pragma unroll
        for (int q = 0; q < NPF; ++q) { const int cur = it + q * NGW;
            if (cur < nitems) {
                f32x4 v[8];
#pragma unroll
                for (int i = 0; i < 8; ++i) v[i] = buf[q][i];
                unsigned char* cdst = bdst[q]; const int cldt = bldt[q];
                if (cur + NPF * NGW < nitems) { TrSrc s; moe_item(wg, wu, wd, cur + NPF * NGW, part, s, bdst[q], bldt[q], gu, dn);
#pragma unroll
                    for (int i = 0; i < 8; ++i) buf[q][i] = *(const f32x4*)(s.p + (size_t)(kr + 8 * i) * s.ldw + nc); }
#pragma unroll
                for (int i = 0; i < 8; ++i) { LAS float* w = scr + (kr + 8 * i) * 33 + nc; const f32x4 t = MOE_F8 ? v[i] * MOEW_SCALE : v[i]; w[0] = t[0]; w[1] = t[1]; w[2] = t[2]; w[3] = t[3]; }
                LDS_WAIT(); asm volatile("" ::: "memory");
                const int c = lane & 7;
#pragma unroll
                for (int j = 0; j < 4; ++j) { const int n = (lane >> 3) + 8 * j; const LAS float* sp = scr + (8 * c) * 33 + n;
                    if constexpr (MOE_F8) { const f32x4 x0 = {sp[0 * 33], sp[1 * 33], sp[2 * 33], sp[3 * 33]}, x1 = {sp[4 * 33], sp[5 * 33], sp[6 * 33], sp[7 * 33]};
                        *(u32x2*)(cdst + (size_t)n * cldt + 8 * c) = pack8_f8(x0, x1); }
                    else { u32x4 o; o.x = cvtpk(sp[0 * 33], sp[1 * 33]); o.y = cvtpk(sp[2 * 33], sp[3 * 33]); o.z = cvtpk(sp[4 * 33], sp[5 * 33]); o.w = cvtpk(sp[6 * 33], sp[7 * 33]);
                        *(u32x4*)(cdst + ((size_t)n * cldt + 8 * c) * 2) = o; } }
                LDS_WAIT(); asm volatile("" ::: "memory");
            } }
    }
}
__device__ __forceinline__ void phase_combine(const bf16* oc, bf16* o, const float* lam, float lambda_init, int gw, int NGW, int lane) {
    const float s1 = wave_sum(lam[lane] * lam[64 + lane], lane), s2 = wave_sum(lam[128 + lane] * lam[192 + lane], lane);
    const float lamf = expf(s1) - expf(s2) + lambda_init;
    for (int row = gw; row < T; row += NGW) {
#pragma unroll
        for (int i = 0; i < 2; ++i) { const int c = lane + 64 * i, head = c >> 4, off = (c & 15) * 8;
            const u32x4 a = *(const u32x4*)(oc + (size_t)row * 2048 + (2 * head) * 128 + off), b = *(const u32x4*)(oc + (size_t)row * 2048 + (2 * head + 1) * 128 + off);
            float d[8];
#pragma unroll
            for (int k = 0; k < 4; ++k) { d[2 * k] = bf_lo(a[k]) - lamf * bf_lo(b[k]); d[2 * k + 1] = bf_hi(a[k]) - lamf * bf_hi(b[k]); }
            float ss = 0.f;
#pragma unroll
            for (int k = 0; k < 8; ++k) ss += d[k] * d[k];
            ss += shx(ss, 1, lane); ss += shx(ss, 2, lane); ss += shx(ss, 4, lane); ss += shx(ss, 8, lane);
            const float r = 1.0f / sqrtf(ss * (1.0f / 128.0f) + LN_EPS);
            u32x4 w; w.x = cvtpk(d[0] * r, d[1] * r); w.y = cvtpk(d[2] * r, d[3] * r); w.z = cvtpk(d[4] * r, d[5] * r); w.w = cvtpk(d[6] * r, d[7] * r);
            *(u32x4*)(o + (size_t)row * D + head * 128 + off) = w; }
    }
}
__device__ __forceinline__ void top2_of4(float a0, float a1, float a2, float a3, int& i0, int& i1, float& v0, float& v1) {
    i0 = 0; v0 = a0; if (a1 > v0) { v0 = a1; i0 = 1; } if (a2 > v0) { v0 = a2; i0 = 2; } if (a3 > v0) { v0 = a3; i0 = 3; }
    v1 = -3.0e38f; i1 = 0;
    if (i0 != 0 && a0 > v1) { v1 = a0; i1 = 0; } if (i0 != 1 && a1 > v1) { v1 = a1; i1 = 1; } if (i0 != 2 && a2 > v1) { v1 = a2; i1 = 2; } if (i0 != 3 && a3 > v1) { v1 = a3; i1 = 3; }
}
__device__ __forceinline__ void route_rows8(const LAS float* Lg, const float* router_b, int lrow_base, int lane, LAS int* cnt, LAS int* pe, LAS int* prank, LAS float* pgate) {
    const int q = lane >> 3, g = lane & 7, lrow = lrow_base + q;
    const f32x4 rb = *(const f32x4*)(router_b + 4 * g);
    float sc[4], sel[4];
#pragma unroll
    for (int i = 0; i < 4; ++i) { sc[i] = 1.0f / (1.0f + expf(-Lg[lrow * 33 + 4 * g + i])); sel[i] = sc[i] + rb[i]; }
    int i0, i1; float v0, v1; top2_of4(sel[0], sel[1], sel[2], sel[3], i0, i1, v0, v1);
    float gs = v0 + v1; int gi = g;
    { const float os = dppf<0xB1>(gs); const int oi = dppi<0xB1>(gi); if (os > gs || (os == gs && oi < gi)) { gs = os; gi = oi; } }
    { const float os = dppf<0x4E>(gs); const int oi = dppi<0x4E>(gi); if (os > gs || (os == gs && oi < gi)) { gs = os; gi = oi; } }
    { const float os = dppf<0x141>(gs); const int oi = dppi<0x141>(gi); if (os > gs || (os == gs && oi < gi)) { gs = os; gi = oi; } }
    if (g == gi) { const float g0 = i0 == 0 ? sc[0] : i0 == 1 ? sc[1] : i0 == 2 ? sc[2] : sc[3], g1 = i1 == 0 ? sc[0] : i1 == 1 ? sc[1] : i1 == 2 ? sc[2] : sc[3];
        const int e0 = 4 * g + i0, e1 = 4 * g + i1; const float inv = 1.0f / (g0 + g1);
        const int r0 = __hip_atomic_fetch_add(cnt + e0, 1, __ATOMIC_RELAXED, __HIP_MEMORY_SCOPE_WORKGROUP), r1 = __hip_atomic_fetch_add(cnt + e1, 1, __ATOMIC_RELAXED, __HIP_MEMORY_SCOPE_WORKGROUP);
        pe[2 * lrow] = e0; pe[2 * lrow + 1] = e1; prank[2 * lrow] = r0; prank[2 * lrow + 1] = r1; pgate[2 * lrow] = g0 * inv; pgate[2 * lrow + 1] = g1 * inv; }
}
__device__ __forceinline__ void phase_ln_router(const bf16* xin, bf16* x16, unsigned char* x8, float* stat, const float* g, const float* b, const bf16* wr_hi, const bf16* wr_lo, const float* router_b,
                                                int* tk_e, int* tk_pos, float* tk_gate, unsigned* gcount, int* list, LAS unsigned char* lds, int tid, int wave, int lane, int bid) {
    LAS int* cnt = (LAS int*)(lds + MISC_OFF + MO_CNT); LAS int* wbase = (LAS int*)(lds + MISC_OFF + MO_WBASE);
    LAS int* pe = (LAS int*)(lds + MISC_OFF + MO_PE); LAS int* prank = (LAS int*)(lds + MISC_OFF + MO_PRANK); LAS float* pgate = (LAS float*)(lds + MISC_OFF + MO_PGATE);
    const int lrow_base = wave * (RPW / NWAVES), row_base = bid * RPW + lrow_base;
    if (tid < 32) cnt[tid] = 0;
    bf16x8 rwh[2][4], rwl[2][4];
    { const int fr_ = lane & 15, kg_ = lane >> 4;
#pragma unroll
      for (int nt = 0; nt < 2; ++nt)
#pragma unroll
        for (int ks = 0; ks < 4; ++ks) { const size_t o_ = (size_t)(16 * nt + fr_) * D + 8 * kg_ + 32 * (4 * wave + ks); rwh[nt][ks] = *(const bf16x8*)(wr_hi + o_); rwl[nt][ks] = *(const bf16x8*)(wr_lo + o_); } }
    f32x4 gl[2][2], bl[2][2];
#pragma unroll
    for (int j = 0; j < 2; ++j)
#pragma unroll
        for (int h = 0; h < 2; ++h) { gl[j][h] = *((const f32x4*)g + 2 * (lane + 64 * j) + h); bl[j][h] = *((const f32x4*)b + 2 * (lane + 64 * j) + h); }
#pragma unroll 1
    for (int it = 0; it < RPW / NWAVES / 4; ++it) {
        u32x4 xw[4][2];
#pragma unroll
        for (int q = 0; q < 4; ++q)
#pragma unroll
            for (int j = 0; j < 2; ++j) xw[q][j] = *((const u32x4*)(xin + (size_t)(row_base + 4 * it + q) * D) + lane + 64 * j);
#pragma unroll
        for (int q = 0; q < 4; ++q) { const int lr = lrow_base + 4 * it + q;
            f32x4 v[2][2]; float s = 0.f;
#pragma unroll
            for (int j = 0; j < 2; ++j)
#pragma unroll
                for (int h = 0; h < 2; ++h) { const unsigned w0 = xw[q][j][2 * h], w1 = xw[q][j][2 * h + 1]; v[j][h][0] = bf_lo(w0); v[j][h][1] = bf_hi(w0); v[j][h][2] = bf_lo(w1); v[j][h][3] = bf_hi(w1);
                    s += (v[j][h][0] + v[j][h][1]) + (v[j][h][2] + v[j][h][3]); }
            const float mean = wave_sum(s, lane) * (1.f / D); float s2 = 0.f;
#pragma unroll
            for (int j = 0; j < 2; ++j)
#pragma unroll
                for (int h = 0; h < 2; ++h) { v[j][h] = v[j][h] - mean; s2 += (v[j][h][0] * v[j][h][0] + v[j][h][1] * v[j][h][1]) + (v[j][h][2] * v[j][h][2] + v[j][h][3] * v[j][h][3]); }
            const float rstd = 1.f / sqrtf(wave_sum(s2, lane) * (1.f / D) + LN_EPS);
            u32x4* o16 = (u32x4*)(x16 + (size_t)(bid * RPW + lr) * D) + lane;
            if (MOE_F8 && lane == 0) { stat[2 * (bid * RPW + lr)] = mean; stat[2 * (bid * RPW + lr) + 1] = rstd; }
#pragma unroll
            for (int j = 0; j < 2; ++j) { const f32x4 n0 = v[j][0] * rstd * gl[j][0] + bl[j][0], n1 = v[j][1] * rstd * gl[j][1] + bl[j][1]; const u32x4 w = pack8(n0, n1); if constexpr (!MOE_F8) o16[64 * j] = w;
                if constexpr (MOE_F8) *((u32x2*)(x8 + (size_t)(bid * RPW + lr) * D) + lane + 64 * j) = pack8_f8(n0, n1);
                const int c = lane + 64 * j;
                *(LAS u32x4*)(lds + lr * 2048 + ((c ^ (lr & 15)) << 4)) = w; }
        }
    }
    __syncthreads();
    {
        typedef float f32x4v __attribute__((ext_vector_type(4)));
        const int fr = lane & 15, kg = lane >> 4;
        f32x4v acc[4][2];
#pragma unroll
        for (int mt = 0; mt < 4; ++mt)
#pragma unroll
            for (int nt = 0; nt < 2; ++nt) acc[mt][nt] = (f32x4v){0.f, 0.f, 0.f, 0.f};
#pragma unroll
        for (int ks = 0; ks < 4; ++ks)
#pragma unroll
            for (int mt = 0; mt < 4; ++mt) { const int lr = 16 * mt + fr, c = 4 * (4 * wave + ks) + kg;
                const bf16x8 a = *(const LAS bf16x8*)(lds + lr * 2048 + ((c ^ (lr & 15)) << 4));
#pragma unroll
                for (int nt = 0; nt < 2; ++nt) { acc[mt][nt] = __builtin_amdgcn_mfma_f32_16x16x32_bf16(a, rwh[nt][ks], acc[mt][nt], 0, 0, 0); acc[mt][nt] = __builtin_amdgcn_mfma_f32_16x16x32_bf16(a, rwl[nt][ks], acc[mt][nt], 0, 0, 0); } }
        __syncthreads();
        LAS float* Pp = (LAS float*)lds + wave * (64 * 33);
#pragma unroll
        for (int mt = 0; mt < 4; ++mt)
#pragma unroll
            for (int nt = 0; nt < 2; ++nt)
#pragma unroll
                for (int j = 0; j < 4; ++j) Pp[(16 * mt + 4 * kg + j) * 33 + 16 * nt + fr] = acc[mt][nt][j];
        __syncthreads();
        LAS float* Lg = (LAS float*)(lds + 8 * 64 * 33 * 4);
        for (int e = tid; e < 64 * 33; e += NTHREADS) { float t = 0.f;
#pragma unroll
            for (int w = 0; w < 8; ++w) t += ((const LAS float*)lds)[w * (64 * 33) + e];
            Lg[e] = t; }
    }
    __syncthreads();
    static_assert(RPW / NWAVES == 8, "route_rows8 handles a wave's eight rows");
    route_rows8((const LAS float*)(lds + 8 * 64 * 33 * 4), router_b, lrow_base, lane, cnt, pe, prank, pgate);
    __syncthreads();
    if (tid < 32) { const int c = cnt[tid]; wbase[tid] = c ? (int)__hip_atomic_fetch_add(gcount + tid, (unsigned)c, __ATOMIC_RELAXED, __HIP_MEMORY_SCOPE_AGENT) : 0; }
    __syncthreads();
    if (tid < 2 * RPW) { const int e = pe[tid], pos = wbase[e] + prank[tid], idx = bid * RPW * 2 + tid;
        tk_e[idx] = e; tk_pos[idx] = pos; tk_gate[idx] = pgate[tid]; list[e * T + pos] = idx >> 1; }
}
__device__ __forceinline__ void phase_ln_moe(const bf16* x16, const float* stat, const float* lng1, const float* lnb1, bf16* x16o, unsigned char* x8, float* xout,
                                              const bf16* y, const int* tk_e, const int* tk_pos, const float* tk_gate, const LAS int* pbase, const float* g, const float* b, int gw, int NGW, int lane) {
    f32x4 gl[2][2], bl[2][2];
#pragma unroll
    for (int j = 0; j < 2; ++j)
#pragma unroll
        for (int h = 0; h < 2; ++h) { gl[j][h] = *((const f32x4*)g + 2 * (lane + 64 * j) + h); bl[j][h] = *((const f32x4*)b + 2 * (lane + 64 * j) + h); }
    f32x4 ga[2][2], ba[2][2];
    if constexpr (MOE_F8) {
#pragma unroll
        for (int j = 0; j < 2; ++j)
#pragma unroll
            for (int h = 0; h < 2; ++h) { ga[j][h] = *((const f32x4*)lng1 + 2 * (lane + 64 * j) + h) * ALPHA; ba[j][h] = *((const f32x4*)lnb1 + 2 * (lane + 64 * j) + h) * ALPHA; } }
#pragma unroll 1
    for (int row0 = gw * (T / NGW); row0 < (gw + 1) * (T / NGW); row0 += 4) {
        int s0[4], s1[4]; float g0[4], g1[4]; float mu[4], rs[4];
        if constexpr (MOE_F8) {
#pragma unroll
            for (int q = 0; q < 4; ++q) { const int row = row0 + q; mu[q] = stat[2 * row]; rs[q] = stat[2 * row + 1]; } }
#pragma unroll
        for (int q = 0; q < 4; ++q) { const int row = row0 + q; s0[q] = pbase[tk_e[2 * row]] * 256 + tk_pos[2 * row]; s1[q] = pbase[tk_e[2 * row + 1]] * 256 + tk_pos[2 * row + 1]; g0[q] = tk_gate[2 * row]; g1[q] = tk_gate[2 * row + 1]; }
        u32x4 xa[4][2], ya[4][2], yc[4][2]; u32x2 ya8[4][2], yc8[4][2];
#pragma unroll
        for (int q = 0; q < 4; ++q) { const int row = row0 + q;
            const u32x4* xr = (const u32x4*)(x16 + (size_t)row * D) + lane; const u32x4* y0 = (const u32x4*)(y + (size_t)s0[q] * D) + lane; const u32x4* y1 = (const u32x4*)(y + (size_t)s1[q] * D) + lane;
            const u32x2* z0 = (const u32x2*)((const unsigned char*)y + (size_t)s0[q] * D) + lane; const u32x2* z1 = (const u32x2*)((const unsigned char*)y + (size_t)s1[q] * D) + lane;
#pragma unroll
            for (int j = 0; j < 2; ++j) { xa[q][j] = xr[64 * j]; if constexpr (Y_F8) { ya8[q][j] = z0[64 * j]; yc8[q][j] = z1[64 * j]; } else { ya[q][j] = y0[64 * j]; yc[q][j] = y1[64 * j]; } } }
#pragma unroll
        for (int q = 0; q < 4; ++q) { const int row = row0 + q;
            f32x4 v[2][2]; float s = 0.f;
#pragma unroll
            for (int j = 0; j < 2; ++j)
#pragma unroll
                for (int h = 0; h < 2; ++h) { const unsigned xw0 = xa[q][j][2 * h], xw1 = xa[q][j][2 * h + 1];
                    if constexpr (Y_F8) { const f32x2 a0 = __builtin_amdgcn_cvt_pk_f32_fp8((int)ya8[q][j][h], false), a1 = __builtin_amdgcn_cvt_pk_f32_fp8((int)ya8[q][j][h], true);
                        const f32x2 c0 = __builtin_amdgcn_cvt_pk_f32_fp8((int)yc8[q][j][h], false), c1 = __builtin_amdgcn_cvt_pk_f32_fp8((int)yc8[q][j][h], true);
                        const float e0 = g0[q] * (1.0f / Y_SCALE), e1 = g1[q] * (1.0f / Y_SCALE);
                        f32x4 xr4 = {bf_lo(xw0), bf_hi(xw0), bf_lo(xw1), bf_hi(xw1)};
                        if constexpr (MOE_F8) xr4 = (xr4 - mu[q]) * rs[q] * ga[j][h] + ba[j][h]; else xr4 = xr4 * ALPHA;
                        v[j][h][0] = xr4[0] + (e0 * a0[0] + e1 * c0[0]); v[j][h][1] = xr4[1] + (e0 * a0[1] + e1 * c0[1]);
                        v[j][h][2] = xr4[2] + (e0 * a1[0] + e1 * c1[0]); v[j][h][3] = xr4[3] + (e0 * a1[1] + e1 * c1[1]); }
                    else { const unsigned aw0 = ya[q][j][2 * h], aw1 = ya[q][j][2 * h + 1], cw0 = yc[q][j][2 * h], cw1 = yc[q][j][2 * h + 1];
                    v[j][h][0] = bf_lo(xw0) * ALPHA + (g0[q] * bf_lo(aw0) + g1[q] * bf_lo(cw0)); v[j][h][1] = bf_hi(xw0) * ALPHA + (g0[q] * bf_hi(aw0) + g1[q] * bf_hi(cw0));
                    v[j][h][2] = bf_lo(xw1) * ALPHA + (g0[q] * bf_lo(aw1) + g1[q] * bf_lo(cw1)); v[j][h][3] = bf_hi(xw1) * ALPHA + (g0[q] * bf_hi(aw1) + g1[q] * bf_hi(cw1)); }
                    s += (v[j][h][0] + v[j][h][1]) + (v[j][h][2] + v[j][h][3]); }
            const float mean = wave_sum(s, lane) * (1.f / D); float s2 = 0.f;
#pragma unroll
            for (int j = 0; j < 2; ++j)
#pragma unroll
                for (int h = 0; h < 2; ++h) { v[j][h] = v[j][h] - mean; s2 += (v[j][h][0] * v[j][h][0] + v[j][h][1] * v[j][h][1]) + (v[j][h][2] * v[j][h][2] + v[j][h][3] * v[j][h][3]); }
            const float rstd = 1.f / sqrtf(wave_sum(s2, lane) * (1.f / D) + LN_EPS);
            if (xout) { f32x4* xw = (f32x4*)(xout + (size_t)row * D);
#pragma unroll
                for (int j = 0; j < 2; ++j)
#pragma unroll
                    for (int h = 0; h < 2; ++h) xw[2 * (lane + 64 * j) + h] = v[j][h] * rstd * gl[j][h] + bl[j][h]; }
            else { u32x4* o16 = (u32x4*)(x16o + (size_t)row * D) + lane; u32x2* o8 = (u32x2*)(x8 + (size_t)row * D) + lane;
#pragma unroll
                for (int j = 0; j < 2; ++j) { const f32x4 n0 = v[j][0] * rstd * gl[j][0] + bl[j][0], n1 = v[j][1] * rstd * gl[j][1] + bl[j][1]; o16[64 * j] = pack8(n0, n1); if (x8) o8[64 * j] = pack8_f8(n0, n1); } }
        }
    }
}

#define CAS __attribute__((address_space(4)))
extern __shared__ __attribute__((aligned(16))) unsigned char lds_raw[];
__device__ __forceinline__ const CAS Args* kargs() { return (const CAS Args*)__builtin_amdgcn_kernarg_segment_ptr(); }
#define PH_COMMON const CAS Args* ka = kargs(); asm volatile("" : "+s"(ka)); unsigned char* ws = ka->ws; LAS unsigned char* lds = (LAS unsigned char*)lds_raw; \
    const int tid = mk_tid(wv); const int lane = tid & 63, wave = wv; int G = gridDim.x, bid = blockIdx.x; asm volatile("" : "+s"(G), "+s"(bid)); const int gw = bid * NWAVES + wave, NGW = G * NWAVES; \
    (void)ws; (void)lds; (void)lane; (void)wave; (void)gw; (void)NGW; (void)G; (void)bid;
#define PH_FN static __device__ __forceinline__ void

__device__ __forceinline__ Args load_args(const CAS Args* ka) { Args a; for (int i = 0; i < 19; ++i) a.in[i] = ka->in[i]; a.out = ka->out; a.ws = ka->ws; a.ph_lo = ka->ph_lo; a.ph_hi = ka->ph_hi; return a; }

PH_FN ph_prologue(int wv) { PH_COMMON const Args a = load_args(ka); phase_prologue(a, lds, gw, NGW, wave, lane); phase_moe_weights(a, 0, 2, lds, gw, NGW, wave, lane); }
PH_FN ph_moe_weights(int wv, int L_) { PH_COMMON const int L = __builtin_amdgcn_readfirstlane(L_); const Args a = load_args(ka); phase_moe_weights(a, L, 2, lds, gw, NGW, wave, lane); }
PH_FN ph_qkv(int wv, int L_) { PH_COMMON const int L = __builtin_amdgcn_readfirstlane(L_);
    pg8::Gemm g{(const bf16*)(ws + WS_X16), (const bf16*)(ws + WS_WQKV) + (size_t)L * 3072 * 1024, T, 3072, 1024}; pg8::StaticOrder S; S.init(T, 3072, G, bid);
    EpiStore E{(bf16*)(ws + WS_RA + RA_QKV), 3072};
    pg8::gemm_phase<EpiStore, pg8::StaticOrder, true, true>(lds, g, S, E, wv); }
PH_FN ph_attn_diff(int wv, int L_) { PH_COMMON const int L = __builtin_amdgcn_readfirstlane(L_);
    const bf16* qkv = (const bf16*)(ws + WS_RA + RA_QKV); bf16* od = (bf16*)(ws + WS_RB + RB_OD);
    const float* lamp = ka->in[2] + L * 256;
    const float s1 = wave_sum(lamp[lane] * lamp[64 + lane], lane), s2 = wave_sum(lamp[128 + lane] * lamp[192 + lane], lane);
    const float lam = expf(s1) - expf(s2) + lambda_init_of(L);
    for (int p = bid; p < 256; p += G) {
        const int gid = (p & 7) * 2 + ((p >> 3) >> 4), k = (p >> 3) & 15;
#pragma unroll 1
        for (int t = 0; t < 2; ++t) { const int combo = gid * 2 + t, qb = t ? 15 - k : k, b = combo >> 3, h = combo & 7;
            const float slope2 = exp2f(-(float)(h + 1)) * LOG2E;
            const bf16* kb = qkv + (size_t)b * SEQ * 3072;
#pragma unroll 1
            for (int cc = 0; cc < 2; ++cc)
                att::unit3<64, true>(kb + (size_t)qb * 256 * 3072 + h * 128 + cc * 64, 3072, kb + 1024 + h * 128 + cc * 64, 3072, nullptr, 0, kb + 2048 + h * 128, 3072,
                                     od + ((size_t)b * SEQ + qb * 256) * 1024 + h * 128, 1024, qb, t != 0, slope2, 1 + cc, lam, lds, wv); }
    } }
PH_FN ph_mla_a(int wv, int j_) { PH_COMMON const int j = __builtin_amdgcn_readfirstlane(j_);
    const int N = j ? 512 : 1024;
    pg8::Gemm g{(const bf16*)(ws + WS_X8), (const bf16*)(ws + (j ? WS_WA1 : WS_WA0)), T, N, 512}; pg8::StaticOrder S; S.init(T, N, G, bid);
    EpiMlaA E{(bf16*)(ws + WS_RA + RA_QA), (unsigned char*)(ws + WS_RA + RA_CKV), (bf16*)(ws + WS_RB + RB_KROPE), (float*)(ws + WS_SSQQ), (float*)(ws + WS_SSQKV), (const float*)(ws + WS_COS), (const float*)(ws + WS_SIN), 1.0f / WA_SCALE};
    pg8::gemm_phase<EpiMlaA, pg8::StaticOrder, true, true, true>(lds, g, S, E, wv); }
PH_FN ph_mla_qb(int wv, int j_) { PH_COMMON const int j = __builtin_amdgcn_readfirstlane(j_);
    pg8::Gemm g{(const bf16*)(ws + WS_RA + RA_QA), (const bf16*)(ws + WS_WQB + j * WQB_STRIDE), T, 1536, 384}; pg8::StaticOrder S; S.init(T, 1536, G, bid);
    EpiQB E{(bf16*)(ws + WS_RA + RA_Q), (const float*)(ws + WS_SSQQ), (const float*)(ws + WS_COS), (const float*)(ws + WS_SIN), 0.07216878364870322f * LOG2E / K8_SCALE};
    pg8::gemm_phase<EpiQB, pg8::StaticOrder, true, true>(lds, g, S, E, wv); }
PH_FN ph_mla_kvb(int wv) { PH_COMMON
    pg8::Gemm g{(const bf16*)(ws + WS_RA + RA_CKV), (const bf16*)(ws + WS_WKVB), T, 2048, 128}; pg8::StaticOrder S; S.init(T, 2048, G, bid);
    EpiKVB E{(bf16*)(ws + WS_RB + RB_KV), (unsigned char*)(ws + WS_K8), (const float*)(ws + WS_SSQKV), 1.0f / WKVB_SCALE};
    pg8::gemm_phase<EpiKVB, pg8::StaticOrder, true, true, true>(lds, g, S, E, wv); }
PH_FN ph_attn_mla(int wv) { PH_COMMON
    const bf16* q = (const bf16*)(ws + WS_RA + RA_Q); bf16* om = (bf16*)(ws + WS_RA + RA_O_MLA); const bf16* kv = (const bf16*)(ws + WS_RB + RB_KV); const bf16* krope = (const bf16*)(ws + WS_RB + RB_KROPE);
    for (int p = bid; p < 256; p += G) {
        const int gid = (p & 7) * 2 + ((p >> 3) >> 4), k = (p >> 3) & 15;
#pragma unroll 1
        for (int t = 0; t < 2; ++t) { const int combo = gid * 2 + t, qb = t ? 15 - k : k, b = combo >> 3, h = combo & 7;
            att::unit3<192, false, true, true>((const bf16*)((const unsigned char*)q + ((size_t)b * SEQ + qb * 256) * 1536 + h * 192), 1536, (const bf16*)(ws + WS_K8 + (size_t)b * SEQ * 1024 + h * 128), 1024, (const bf16*)((const unsigned char*)krope + (size_t)b * SEQ * 64), 64,
                                  kv + (size_t)b * SEQ * 2048 + h * 256 + 128, 2048, (bf16*)((unsigned char*)om + ((size_t)b * SEQ + qb * 256) * 1024 + h * 128), 1024, qb, t != 0, 0.f, 0, 0.f, lds, wv); }
    } }
PH_FN ph_wo(int wv, int L_, bool dummy) { PH_COMMON const int L = __builtin_amdgcn_readfirstlane(L_);
    pg8::StaticOrder S; S.init(T, 1024, G, bid);
    if (L < 2) { pg8::Gemm g{(const bf16*)(ws + WS_RB + RB_OD), (const bf16*)(ws + WS_WO) + (size_t)L * 1024 * 1024, T, 1024, 1024};
        EpiRes E{L == 0 ? ka->in[0] : (const float*)nullptr, (const bf16*)(ws + WS_X16), (bf16*)(ws + WS_XPRE), 1.0f};
        pg8::gemm_phase<EpiRes, pg8::StaticOrder, true, true>(lds, g, S, E, wv); }
    else {
        pg8::Gemm g{(const bf16*)(ws + WS_RA + RA_O_MLA), (const bf16*)(ws + WS_WMO + (size_t)(L - 2) * 1024 * 1024), T, 1024, 512};
        EpiRes E{(const float*)nullptr, (const bf16*)(ws + WS_X16), (bf16*)(ws + WS_XPRE), 1.0f / (att::O8_SCALE * WMO_SCALE)};
        pg8::gemm_phase<EpiRes, pg8::StaticOrder, true, true, true>(lds, g, S, E, wv); } }
PH_FN ph_ln_router(int wv, int L_) { PH_COMMON const int L = __builtin_amdgcn_readfirstlane(L_);
    if (PROBE_DUP == 7) { phase_ln_router((const bf16*)(ws + WS_XPRE), (bf16*)(ws + WS_RA), (unsigned char*)(ws + WS_RA + 32 * MiB), (float*)(ws + WS_RA + 52 * MiB), ka->in[17] + (size_t)(L * 2) * D, ka->in[18] + (size_t)(L * 2) * D, (const bf16*)(ws + WS_RTW), (const bf16*)(ws + WS_RTW) + 32 * 1024, ka->in[13],
                    (int*)(ws + WS_RA + 48 * MiB), (int*)(ws + WS_RA + 49 * MiB), (float*)(ws + WS_RA + 50 * MiB), (unsigned*)(ws + WS_CTL) + CW_GCOUNT + (4 + L) * 64, (int*)(ws + WS_Y), lds, tid, wave, lane, bid); __syncthreads(); }
    phase_ln_router((const bf16*)(ws + WS_XPRE), (bf16*)(ws + WS_X16), (unsigned char*)(ws + WS_X8), (float*)(ws + WS_STAT), ka->in[17] + (size_t)(L * 2) * D, ka->in[18] + (size_t)(L * 2) * D, (const bf16*)(ws + WS_RTW), (const bf16*)(ws + WS_RTW) + 32 * 1024, ka->in[13],
                    (int*)(ws + WS_TKE), (int*)(ws + WS_TKPOS), (float*)(ws + WS_TKGATE), (unsigned*)(ws + WS_CTL) + CW_GCOUNT + L * 64, (int*)(ws + WS_LIST), lds, tid, wave, lane, bid); }
PH_FN ph_up(int wv, int L_) { PH_COMMON const int L = __builtin_amdgcn_readfirstlane(L_);
    LAS int* pbase = (LAS int*)(lds + MISC_OFF + MO_PBASE); LAS int* ne = (LAS int*)(lds + MISC_OFF + MO_NE);
    LAS int* utab = (LAS int*)(lds + MISC_OFF + MO_UTAB);
    moe_table((const unsigned*)(ws + WS_CTL) + CW_GCOUNT + L * 64, pbase, ne, wave, lane); __syncthreads();
    const int xq = bid & 7, yq = bid >> 3, YN = G >> 3, nunits = pbase[32] * 2;
    int gwx = YN; if (L < 3) { gwx = (nunits + 15) >> 4; gwx = gwx < YN / 2 ? YN / 2 : gwx; gwx = gwx > YN ? YN : gwx; }
    moe_units<2>(pbase, utab, 8 * gwx, xq * gwx + (yq < gwx ? yq : 0), wave, lane); __syncthreads();
    if (yq < gwx) {
        pg8::Gemm g{(const bf16*)(ws + (MOE_F8 ? WS_X8 : WS_X16)), (const bf16*)(ws + ((L & 1) ? WS_MOEW2 : WS_MOEGU)), T, NE * 512, 512 * MOE_ES}; MoeOrd<2, true> S; S.init(pbase, ne, utab, (const int*)(ws + WS_LIST));
        EpiUp E{(bf16*)(ws + WS_RA + RA_H), MOE_F8 ? 1.0f / MOEW_SCALE : 1.0f};
        pg8::gemm_phase<EpiUp, MoeOrd<2, true>, true, true, MOE_F8>(lds, g, S, E, wv);
        if (L < 3 && gwx == YN) { __syncthreads(); const Args a = load_args(ka); const int vcu = xq * YN + yq; phase_moe_weights(a, L + 1, 2, lds, vcu * NWAVES + wv, G * NWAVES, wv, mk_lane()); }
    } else { const Args a = load_args(ka); phase_moe_weights(a, L + 1, 2, lds, (xq * (YN - gwx) + (yq - gwx)) * NWAVES + wv, 8 * (YN - gwx) * NWAVES, wv, mk_lane()); }
}
PH_FN ph_down(int wv, int L_) { PH_COMMON const int L = __builtin_amdgcn_readfirstlane(L_);
    LAS int* pbase = (LAS int*)(lds + MISC_OFF + MO_PBASE); LAS int* ne = (LAS int*)(lds + MISC_OFF + MO_NE);
    LAS int* utab = (LAS int*)(lds + MISC_OFF + MO_UTAB);
    if (!MK_SINGLE) { moe_table((const unsigned*)(ws + WS_CTL) + CW_GCOUNT + L * 64, pbase, ne, wave, lane); __syncthreads(); }
    moe_units<4>(pbase, utab, G, (bid & 7) * (G >> 3) + (bid >> 3), wave, lane); __syncthreads();
    pg8::Gemm g{(const bf16*)(ws + WS_RA + RA_H), (const bf16*)(ws + ((L & 1) ? WS_MOEW2 + 32 * MiB : WS_MOED)), SLOT_CAP, NE * 1024, 128 * MOE_ES}; MoeOrd<4, false> S; S.init(pbase, ne, utab, nullptr);
    EpiDown E{(bf16*)(ws + WS_Y), (MOE_F8 ? 1.0f / (MOEW_SCALE * H_SCALE) : 1.0f) * (Y_F8 ? Y_SCALE : 1.0f)};
    pg8::gemm_phase<EpiDown, MoeOrd<4, false>, true, true, MOE_F8>(lds, g, S, E, wv);
}
PH_FN ph_ln_moe(int wv, int L_) { PH_COMMON const int L = __builtin_amdgcn_readfirstlane(L_);
    LAS int* pbase = (LAS int*)(lds + MISC_OFF + MO_PBASE); LAS int* ne = (LAS int*)(lds + MISC_OFF + MO_NE);
    if (!MK_SINGLE) { moe_table((const unsigned*)(ws + WS_CTL) + CW_GCOUNT + L * 64, pbase, ne, wave, lane); __syncthreads(); }
    if (PROBE_DUP == 8) { phase_ln_moe((const bf16*)(ws + (MOE_F8 ? WS_XPRE : WS_X16)), (const float*)(ws + WS_STAT), ka->in[17] + (size_t)(L * 2) * D, ka->in[18] + (size_t)(L * 2) * D, (bf16*)(ws + WS_RA), (unsigned char*)(ws + WS_RA + 32 * MiB), (float*)nullptr, (const bf16*)(ws + WS_Y), (const int*)(ws + WS_TKE), (const int*)(ws + WS_TKPOS), (const float*)(ws + WS_TKGATE), pbase,
                 ka->in[17] + (size_t)(L * 2 + 1) * D, ka->in[18] + (size_t)(L * 2 + 1) * D, gw, NGW, lane); __syncthreads(); }
    phase_ln_moe((const bf16*)(ws + (MOE_F8 ? WS_XPRE : WS_X16)), (const float*)(ws + WS_STAT), ka->in[17] + (size_t)(L * 2) * D, ka->in[18] + (size_t)(L * 2) * D, (bf16*)(ws + WS_X16), (L == 1 || L == 2) ? (unsigned char*)(ws + WS_X8) : (unsigned char*)nullptr, L == 3 ? ka->out : (float*)nullptr, (const bf16*)(ws + WS_Y), (const int*)(ws + WS_TKE), (const int*)(ws + WS_TKPOS), (const float*)(ws + WS_TKGATE), pbase,
                 ka->in[17] + (size_t)(L * 2 + 1) * D, ka->in[18] + (size_t)(L * 2 + 1) * D, gw, NGW, lane); }

constexpr int NPH = 31;
__global__ void __launch_bounds__(NTHREADS, 2) mk_fwd(Args a) {
    LAS unsigned char* lds = (LAS unsigned char*)lds_raw;
    const int wv = __builtin_amdgcn_readfirstlane((int)threadIdx.x >> 6); const int tid = mk_tid(wv);
    volatile LAS unsigned* MISC = (volatile LAS unsigned*)(lds + MISC_OFF);
    if (tid < 64) MISC[tid] = 0u;
    __syncthreads();
#if MK_SINGLE
    XcdBarrier bar = xcd_barrier_post((unsigned*)(a.ws + WS_CTL) + 4096, MISC, wv);
#define SEAM() do { if (ph + 1 < hi) { xcd_barrier(bar, wv); if (PROBE_DUP == 11) xcd_barrier(bar, wv); } } while (0)
#else
#define SEAM() do { } while (0)
#endif
    const int lo = a.ph_lo, hi = a.ph_hi;
    int ph = 0;
#define IN_PHASE (ph >= lo && ph < hi)
#define NEXT_PHASE() do { if (IN_PHASE) SEAM(); ++ph; } while (0)

    if (IN_PHASE) { ph_prologue(wv); if (PROBE_DUP == 6) { __syncthreads(); ph_prologue(wv); } }
    NEXT_PHASE();
    for (int L = 0; L < 4; ++L) {
        if (L < 2) {
            if (IN_PHASE) { ph_qkv(wv, L); if (PROBE_DUP == 3) ph_qkv(wv, L); }
            NEXT_PHASE();
            if (IN_PHASE) { ph_attn_diff(wv, L); if (PROBE_DUP == 1) { __syncthreads(); ph_attn_diff(wv, L); } }
            NEXT_PHASE();
        } else {
            if (IN_PHASE) { ph_mla_a(wv, L - 2); if (PROBE_DUP == 3) ph_mla_a(wv, L - 2); }
            NEXT_PHASE();
            if (IN_PHASE) { ph_mla_qb(wv, L - 2); if (L == 2) ph_mla_kvb(wv); if (PROBE_DUP == 3) { ph_mla_qb(wv, L - 2); if (L == 2) ph_mla_kvb(wv); } }
            NEXT_PHASE();
            if (IN_PHASE) { ph_attn_mla(wv); if (PROBE_DUP == 2) { __syncthreads(); ph_attn_mla(wv); } }
            NEXT_PHASE();
        }
        if (IN_PHASE) { if (PROBE_DUP == 9) ph_wo(wv, L, true); ph_wo(wv, L, false); }  NEXT_PHASE();
        if (IN_PHASE) ph_ln_router(wv, L);  NEXT_PHASE();
        if (IN_PHASE) { ph_up(wv, L); if (PROBE_DUP == 4) { __syncthreads(); ph_up(wv, L); } }             NEXT_PHASE();
        if (IN_PHASE) { ph_down(wv, L); if (PROBE_DUP == 4) { __syncthreads(); ph_down(wv, L); } }           NEXT_PHASE();
        if (IN_PHASE) ph_ln_moe(wv, L);  NEXT_PHASE();
    }
}

extern "C" void kernel_launch(void* const* d_in, const int* in_sizes, int n_in, void* d_out, int out_size, void* d_ws, size_t ws_size, hipStream_t stream) {
    static int ok = 0;
    if (!ok) {
        if (n_in != 19 || out_size != T * D || ws_size < WS_END) { fprintf(stderr, "kernel_launch: unexpected shapes: n_in %d out %d ws %zu (need %zu)\n", n_in, out_size, ws_size, (size_t)WS_END); return; }
        if (hipFuncSetAttribute((const void*)mk_fwd, hipFuncAttributeMaxDynamicSharedMemorySize, LDS_BYTES) != hipSuccess) { fprintf(stderr, "kernel_launch: hipFuncSetAttribute failed\n"); return; }
        ok = 1;
    }
    Args a{};
    for (int i = 0; i < 19; ++i) a.in[i] = (const float*)d_in[i];
    a.out = (float*)d_out; a.ws = (unsigned char*)d_ws;
    if (hipMemsetAsync((char*)d_ws + WS_CTL, 0, CTL_ZERO_BYTES, stream) != hipSuccess) { fprintf(stderr, "kernel_launch: memset failed\n"); return; }
#if MK_SINGLE
    a.ph_lo = 0; a.ph_hi = NPH;
    hipLaunchKernelGGL(mk_fwd, dim3(GRID), dim3(NTHREADS), LDS_BYTES, stream, a);
#else
    for (int p = 0; p < NPH; ++p) { a.ph_lo = p; a.ph_hi = p + 1; hipLaunchKernelGGL(mk_fwd, dim3(GRID), dim3(NTHREADS), LDS_BYTES, stream, a); }
#endif
    const hipError_t le = hipPeekAtLastError();
    if (le != hipSuccess) fprintf(stderr, "kernel_launch: launch failed: %s\n", hipGetErrorName(le));
}
```

```cpp
#include <hip/hip_runtime.h>
#include <cstdio>
#include <cstdint>

#ifndef MK_SINGLE
#define MK_SINGLE 1
#endif

#ifndef PROBE_DUP
#define PROBE_DUP 0
#endif

__device__ __forceinline__ int mk_lane() { int l; asm volatile("v_mbcnt_lo_u32_b32 %0, -1, 0\n\tv_mbcnt_hi_u32_b32 %0, -1, %0" : "=v"(l)); return l; }
__device__ __forceinline__ int mk_tid(int wv) { return wv * 64 + mk_lane(); }

namespace pg8 {
#define PG8_LAS __attribute__((address_space(3)))
typedef unsigned short bf16_t;
typedef short bf16x8 __attribute__((ext_vector_type(8)));
typedef float f32x4 __attribute__((ext_vector_type(4)));
typedef unsigned u32x4 __attribute__((ext_vector_type(4)));
constexpr int BM = 256, BK = 64, HALF = 128, HTB = HALF * BK * 2  , STAGE_BYTES = 8 * HTB, NXCD = 8, WGM = 8;

__host__ __device__ __forceinline__ int lds_byte(int r, int c) { const int st = (r >> 4) * 2 + (c >> 5), rr = r & 15, cc = c & 31, ob = rr * 64 + cc * 2; return st * 1024 + (ob ^ (((ob >> 9) & 1) << 5)); }
__host__ __device__ __forceinline__ void stage_rc(int b, int& R, int& C) { const int st = b / 1024, sb = b % 1024, swz = sb ^ (((sb >> 9) & 1) << 5); R = (st >> 1) * 16 + swz / 64; C = (st & 1) * 32 + (swz % 64) / 2; }
__host__ __device__ __forceinline__ int perm32(int rho) { const int n = rho >> 4, i = rho & 15; return 8 * (i >> 2) + 4 * n + (i & 3); }

struct Unit { int pm, pn; };
struct Gemm { const bf16_t* A; const bf16_t* Bt; int M, N, K; };

struct StaticOrder {
    static constexpr bool GATHER = false;
    __device__ __forceinline__ unsigned row_off(const Unit&, int) const { return 0u; }
    int nM, nN, nwg, G, c, inv;
    __host__ __device__ void init(int M, int N, int G_, int c_) { nM = M / BM; nN = N / BM; nwg = nM * nN; G = G_; c = c_; inv = (65536 + nN - 1) / nN; }
    __host__ __device__ bool next(int i, Unit& u) const {
        const int L = i * G + c; if (L >= nwg) return false;
        const int wgid = (L & (NXCD - 1)) * (nwg / NXCD) + (L / NXCD);
        const int a = wgid & (WGM - 1), b = wgid / WGM, gid = (b * inv) >> 16;
        u.pm = gid * WGM + a; u.pn = b - gid * nN; return true;
    }
    __device__ __forceinline__ void a_ready(const Unit&) const {}
    __device__ __forceinline__ void done(const Unit&) const {}
};

__device__ __forceinline__ unsigned cvt_pk_bf16(float lo, float hi) { unsigned r; asm volatile("v_cvt_pk_bf16_f32 %0, %1, %2" : "=v"(r) : "v"(lo), "v"(hi)); return r; }
typedef int i32x8 __attribute__((ext_vector_type(8)));
typedef int i32x4 __attribute__((ext_vector_type(4)));
__device__ __forceinline__ i32x8 cat8(bf16x8 a, bf16x8 b) { const i32x4 x = __builtin_bit_cast(i32x4, a), y = __builtin_bit_cast(i32x4, b); return (i32x8){x[0], x[1], x[2], x[3], y[0], y[1], y[2], y[3]}; }
template <class Epi, class Sched, bool ALIGN_EPI = false, bool SP2 = false, bool F8 = false>
__device__ __forceinline__ void gemm_phase(PG8_LAS unsigned char* lds, const Gemm g, const Sched& S, const Epi& E, int wv) {
    int tid = mk_tid(wv);
    const int wid = __builtin_amdgcn_readfirstlane(tid >> 6), lane = tid & 63, wr = wid >> 2, wc = wid & 3, fr = lane & 15, fq = lane >> 4;
    const int K = g.K, nt = K / BK;
    unsigned voffA[2], voffB[2]; int rowA[2]; unsigned colA2[2];
#pragma unroll
    for (int i = 0; i < 2; ++i) { int R, C; stage_rc(tid * 16 + i * 8192, R, C); const int Rb = Epi::PERM ? ((R & ~31) + perm32(R & 31)) : R;
        voffA[i] = (unsigned)(R * K + C) * 2u; voffB[i] = (unsigned)(Rb * K + C) * 2u; rowA[i] = R; colA2[i] = (unsigned)C * 2u; }
    static_assert(!Sched::GATHER || SP2, "gather mode is written for the SP2 loop");
    unsigned gvc[2][2] = {{0u, 0u}, {0u, 0u}}, gvn[2][2] = {{0u, 0u}, {0u, 0u}};
#define PG8_GOFFS(dst, unit) do { _Pragma("unroll") for (int _h = 0; _h < 2; ++_h) _Pragma("unroll") for (int _i = 0; _i < 2; ++_i) dst[_h][_i] = S.row_off(unit, _h * HALF + rowA[_i]) + colA2[_i]; } while (0)
#define PG8_STAGE_A(bufoff, gbase, H, ARR) do { if constexpr (Sched::GATHER) { PG8_STAGE_R(rsA, bufoff, gbase, ARR[H]); } else { PG8_STAGE_R(rsA, bufoff, (gbase) + (H) * hstep, voffA); } } while (0)
    const unsigned kstep = (unsigned)(BK * 2);
    const unsigned hstep = (unsigned)HALF * (unsigned)K * 2u;
    const unsigned tstep = 2u * hstep;
    const unsigned ldsw = (unsigned)wid * 1024u;
    const int aoff = lds_byte(wr * 64 + fr, fq * 8), boff = lds_byte(wc * 32 + fr, fq * 8);
#define PG8_SA(b, h) (((b) * 2 + (h)) * HTB)
#define PG8_SB(b, h) ((4 + (b) * 2 + (h)) * HTB)
    const __amdgpu_buffer_rsrc_t rsA = __builtin_amdgcn_make_buffer_rsrc((void*)g.A, 0, 0x7fffffff, 0x00020000), rsB = __builtin_amdgcn_make_buffer_rsrc((void*)g.Bt, 0, 0x7fffffff, 0x00020000);
#define PG8_STAGE_R(RS, bufoff, goff, voff) do { _Pragma("unroll") for (int _i = 0; _i < 2; ++_i) \
        __builtin_amdgcn_raw_ptr_buffer_load_lds(RS, (PG8_LAS unsigned*)(lds + (bufoff) + ldsw + _i * 8192), 16, (voff)[_i], (goff), 0, 0); } while (0)
#define PG8_LDA(dst, b, h) do { _Pragma("unroll") for (int m = 0; m < 4; ++m) _Pragma("unroll") for (int k = 0; k < 2; ++k) dst[m][k] = *(const PG8_LAS bf16x8*)(lds + PG8_SA(b, h) + aoff + m * 2048 + k * 1024); } while (0)
#define PG8_LDB(dst, b, h) do { _Pragma("unroll") for (int n = 0; n < 2; ++n) _Pragma("unroll") for (int k = 0; k < 2; ++k) dst[n][k] = *(const PG8_LAS bf16x8*)(lds + PG8_SB(b, h) + boff + n * 2048 + k * 1024); } while (0)
#define PG8_MMA(ai, bj, At, Bt) do { __builtin_amdgcn_s_setprio(1); _Pragma("unroll") for (int m = 0; m < 4; ++m) _Pragma("unroll") for (int n = 0; n < 2; ++n) { \
        if constexpr (F8) acc[ai][bj][m][n] = __builtin_amdgcn_mfma_scale_f32_16x16x128_f8f6f4(cat8(Bt[n][0], Bt[n][1]), cat8(At[m][0], At[m][1]), acc[ai][bj][m][n], 0, 0, 0, 0, 0, 0); \
        else { _Pragma("unroll") for (int k = 0; k < 2; ++k) acc[ai][bj][m][n] = __builtin_amdgcn_mfma_f32_16x16x32_bf16(Bt[n][k], At[m][k], acc[ai][bj][m][n], 0, 0, 0); } } __builtin_amdgcn_s_setprio(0); } while (0)
#define PG8_WAIT_V(n) asm volatile("s_waitcnt vmcnt(" #n ")" ::: "memory")
#define PG8_WAIT_L(n) asm volatile("s_waitcnt lgkmcnt(" #n ")" ::: "memory")
#define PG8_BAR __builtin_amdgcn_s_barrier()
#define PG8_SCHED __builtin_amdgcn_sched_barrier(0)
    Unit cur, nxt; int ui = 0;
    if (!S.next(0, cur)) return;
    f32x4 acc[2][2][4][2];
#pragma unroll
    for (int a = 0; a < 2; ++a)
#pragma unroll
        for (int b = 0; b < 2; ++b)
#pragma unroll
            for (int m = 0; m < 4; ++m)
#pragma unroll
                for (int n = 0; n < 2; ++n) acc[a][b][m][n] = (f32x4){0.f, 0.f, 0.f, 0.f};
    bf16x8 At[4][2], B0[2][2], B1[2][2];
    unsigned cA = Sched::GATHER ? 0u : (unsigned)cur.pm * tstep, cB = (unsigned)cur.pn * tstep;
    if constexpr (Sched::GATHER) PG8_GOFFS(gvc, cur);
    S.a_ready(cur);
    if constexpr (SP2) {
        PG8_STAGE_R(rsB, PG8_SB(0, 0), cB, voffB); PG8_STAGE_R(rsB, PG8_SB(0, 1), cB + hstep, voffB); PG8_STAGE_A(PG8_SA(0, 0), cA, 0, gvc); PG8_STAGE_A(PG8_SA(0, 1), cA, 1, gvc);
        if (wr == 1) PG8_BAR;
        PG8_WAIT_V(2); PG8_BAR;
        PG8_STAGE_R(rsB, PG8_SB(1, 0), cB + kstep, voffB); PG8_STAGE_A(PG8_SA(1, 0), cA + kstep, 0, gvc); PG8_STAGE_R(rsB, PG8_SB(1, 1), cB + hstep + kstep, voffB);
        PG8_WAIT_V(6); PG8_BAR;
    } else {
        PG8_STAGE_R(rsB, PG8_SB(0, 0), cB, voffB); PG8_STAGE_R(rsA, PG8_SA(0, 0), cA, voffA); PG8_STAGE_R(rsB, PG8_SB(0, 1), cB + hstep, voffB); PG8_STAGE_R(rsA, PG8_SA(0, 1), cA + hstep, voffA);
        if (wr == 1) PG8_BAR;
        PG8_WAIT_V(4); PG8_BAR;
        PG8_STAGE_R(rsB, PG8_SB(1, 0), cB + kstep, voffB); PG8_STAGE_R(rsA, PG8_SA(1, 0), cA + kstep, voffA); PG8_STAGE_R(rsB, PG8_SB(1, 1), cB + hstep + kstep, voffB);
        PG8_WAIT_V(6); PG8_BAR;
    }
    for (;;) {
        const bool has_next = S.next(ui + 1, nxt);
        const unsigned nA = (has_next && !Sched::GATHER) ? (unsigned)nxt.pm * tstep : cA, nB = has_next ? (unsigned)nxt.pn * tstep : cB;
        if constexpr (Sched::GATHER) { if (has_next) PG8_GOFFS(gvn, nxt); else {
#pragma unroll
            for (int _h = 0; _h < 2; ++_h)
#pragma unroll
                for (int _i = 0; _i < 2; ++_i) gvn[_h][_i] = gvc[_h][_i]; } }
#pragma unroll 1
        for (int t = 0; t < nt; t += 2) {
            const bool last = (t == nt - 2);
            const unsigned a1 = cA + (unsigned)(t + 1) * kstep;
            const unsigned a2 = last ? nA : cA + (unsigned)(t + 2) * kstep, b2 = last ? nB : cB + (unsigned)(t + 2) * kstep;
            const unsigned a3 = a2 + kstep, b3 = b2 + kstep;
            if (last && has_next) S.a_ready(nxt);
            if constexpr (SP2) {
            PG8_LDB(B0, 0, 0); PG8_LDB(B1, 0, 1); PG8_SCHED; PG8_LDA(At, 0, 0); PG8_STAGE_A(PG8_SA(1, 1), a1, 1, gvc);
            if constexpr (Sched::GATHER) { if (last) {
#pragma unroll
                for (int _h = 0; _h < 2; ++_h)
#pragma unroll
                    for (int _i = 0; _i < 2; ++_i) gvc[_h][_i] = gvn[_h][_i]; } }
            PG8_WAIT_V(8); PG8_WAIT_L(0); PG8_BAR; PG8_MMA(0, 0, At, B0); PG8_MMA(0, 1, At, B1); PG8_BAR; PG8_SCHED;
            PG8_LDA(At, 0, 1); PG8_STAGE_R(rsB, PG8_SB(0, 0), b2, voffB); PG8_STAGE_R(rsB, PG8_SB(0, 1), b2 + hstep, voffB); PG8_STAGE_A(PG8_SA(0, 0), a2, 0, gvc);
            PG8_WAIT_V(8); PG8_WAIT_L(0); PG8_BAR; PG8_MMA(1, 0, At, B0); PG8_MMA(1, 1, At, B1); PG8_BAR; PG8_SCHED;
            PG8_LDB(B0, 1, 0); PG8_LDB(B1, 1, 1); PG8_SCHED; PG8_LDA(At, 1, 0); PG8_STAGE_A(PG8_SA(0, 1), a2, 1, gvc);
            PG8_WAIT_V(8); PG8_WAIT_L(0); PG8_BAR; PG8_MMA(0, 0, At, B0); PG8_MMA(0, 1, At, B1); PG8_BAR; PG8_SCHED;
            PG8_LDA(At, 1, 1); PG8_STAGE_R(rsB, PG8_SB(1, 0), b3, voffB); PG8_STAGE_R(rsB, PG8_SB(1, 1), b3 + hstep, voffB); PG8_STAGE_A(PG8_SA(1, 0), a3, 0, gvc);
            PG8_WAIT_V(8); PG8_WAIT_L(0); PG8_BAR; PG8_MMA(1, 0, At, B0); PG8_MMA(1, 1, At, B1); PG8_BAR; PG8_SCHED;
            } else {
            PG8_LDB(B0, 0, 0); PG8_SCHED; PG8_LDA(At, 0, 0); PG8_STAGE_R(rsA, PG8_SA(1, 1), a1 + hstep, voffA);
            PG8_WAIT_L(8); PG8_BAR; PG8_WAIT_L(0); PG8_MMA(0, 0, At, B0); PG8_BAR; PG8_SCHED;
            PG8_LDB(B1, 0, 1); PG8_STAGE_R(rsB, PG8_SB(0, 0), b2, voffB);
            PG8_BAR; PG8_WAIT_L(0); PG8_MMA(0, 1, At, B1); PG8_BAR;
            PG8_LDA(At, 0, 1); PG8_STAGE_R(rsA, PG8_SA(0, 0), a2, voffA);
            PG8_BAR; PG8_WAIT_L(0); PG8_MMA(1, 0, At, B0); PG8_BAR; PG8_SCHED;
            PG8_STAGE_R(rsB, PG8_SB(0, 1), b2 + hstep, voffB);
            PG8_WAIT_V(6); PG8_BAR; PG8_MMA(1, 1, At, B1); PG8_BAR;
            PG8_LDB(B0, 1, 0); PG8_SCHED; PG8_LDA(At, 1, 0); PG8_STAGE_R(rsA, PG8_SA(0, 1), a2 + hstep, voffA);
            PG8_WAIT_L(8); PG8_BAR; PG8_WAIT_L(0); PG8_MMA(0, 0, At, B0); PG8_BAR; PG8_SCHED;
            PG8_LDB(B1, 1, 1); PG8_STAGE_R(rsB, PG8_SB(1, 0), b3, voffB);
            PG8_BAR; PG8_WAIT_L(0); PG8_MMA(0, 1, At, B1); PG8_BAR;
            PG8_LDA(At, 1, 1); PG8_STAGE_R(rsA, PG8_SA(1, 0), a3, voffA);
            PG8_BAR; PG8_WAIT_L(0); PG8_MMA(1, 0, At, B0); PG8_BAR; PG8_SCHED;
            PG8_STAGE_R(rsB, PG8_SB(1, 1), b3 + hstep, voffB);
            PG8_WAIT_V(6); PG8_BAR; PG8_MMA(1, 1, At, B1); PG8_BAR;
            }
        }
        if constexpr (ALIGN_EPI) { if (wr == 0) PG8_BAR; }
        if constexpr (!Epi::AFTER_DRAIN) { E(acc, cur, wr, wc, fr, fq); S.done(cur); }
        if (!has_next) break;
#pragma unroll
        for (int a = 0; a < 2; ++a)
#pragma unroll
            for (int b = 0; b < 2; ++b)
#pragma unroll
                for (int m = 0; m < 4; ++m)
#pragma unroll
                    for (int n = 0; n < 2; ++n) acc[a][b][m][n] = (f32x4){0.f, 0.f, 0.f, 0.f};
        cur = nxt; cA = nA; cB = nB; ++ui;
        if constexpr (Sched::GATHER) {
#pragma unroll
            for (int _h = 0; _h < 2; ++_h)
#pragma unroll
                for (int _i = 0; _i < 2; ++_i) gvc[_h][_i] = gvn[_h][_i]; }
        if constexpr (ALIGN_EPI) { if (wr == 1) PG8_BAR; }
    }
    PG8_WAIT_V(0);
    if constexpr (!ALIGN_EPI) { if (wr == 0) PG8_BAR; }
    PG8_BAR;
    if constexpr (Epi::AFTER_DRAIN) { E.fused(acc, cur, wr, wc, fr, fq, lds, wid, lane); S.done(cur); }
#undef PG8_SA
#undef PG8_GOFFS
#undef PG8_STAGE_A
#undef PG8_SB
#undef PG8_STAGE_R
#undef PG8_LDA
#undef PG8_LDB
#undef PG8_MMA
#undef PG8_WAIT_V
#undef PG8_WAIT_L
#undef PG8_BAR
#undef PG8_SCHED
}
}

#define LAS __attribute__((address_space(3)))
typedef unsigned short bf16;
typedef short bf16x8 __attribute__((ext_vector_type(8)));
typedef short s16x4 __attribute__((ext_vector_type(4)));
typedef float f32x4 __attribute__((ext_vector_type(4)));
typedef float f32x16 __attribute__((ext_vector_type(16)));
typedef float f32x2 __attribute__((ext_vector_type(2)));
typedef unsigned u32x4 __attribute__((ext_vector_type(4)));
typedef unsigned u32x2 __attribute__((ext_vector_type(2)));

constexpr int T = 16384, D = 1024, SEQ = 4096, NBATCH = 4, NE = 32, FFE = 256;
constexpr int NWAVES = 8, NTHREADS = 512, GRID = 256;
constexpr float LN_EPS = 1e-5f, ALPHA = 1.6817928305074290f;
constexpr float LOG2E = 1.4426950408889634f;
constexpr float WA_SCALE = 32.0f, WKVB_SCALE = 16.0f, WMO_SCALE = 64.0f;
constexpr float K8_SCALE = 0.25f;
#ifndef MK_MOE_F8
#define MK_MOE_F8 1
#endif
constexpr bool MOE_F8 = MK_MOE_F8 != 0;
constexpr float MOEW_SCALE = 32.0f, H_SCALE = 4.0f;
constexpr bool Y_F8 = MOE_F8;
constexpr float Y_SCALE = 16.0f;
constexpr int MOE_ES = MOE_F8 ? 1 : 2;
constexpr int SLOT_CAP = 40960, MAXPANELS = SLOT_CAP / 256;
constexpr int RPW = T / GRID;

constexpr size_t MiB = 1u << 20, KiB = 1u << 10;
constexpr size_t WS_CTL = 0, CTL_ZERO_BYTES = 64 * KiB;
constexpr size_t WS_COS = 1 * MiB, WS_SIN = WS_COS + 512 * KiB;
constexpr size_t WS_SSQQ = 2 * MiB;
constexpr size_t WS_SSQKV = WS_SSQQ + 512 * KiB;
constexpr size_t WS_TKE = 3 * MiB, WS_TKPOS = WS_TKE + 128 * KiB, WS_TKGATE = WS_TKPOS + 128 * KiB, WS_STAT = WS_TKGATE + 128 * KiB;

constexpr size_t WS_WQKV = 4 * MiB;
constexpr size_t WS_WO = 16 * MiB;
constexpr size_t WS_WA0 = 20 * MiB, WS_WA1 = 22 * MiB;
constexpr size_t WS_WQB = 23 * MiB, WQB_STRIDE = 1280 * KiB;
constexpr size_t WS_WKVB = 26 * MiB;
constexpr size_t WS_WMO = 27 * MiB;
constexpr size_t WS_MOEGU = 32 * MiB;
constexpr size_t WS_MOED = 64 * MiB;
constexpr size_t WS_X16 = 80 * MiB;
constexpr size_t WS_RA = 112 * MiB;
constexpr size_t WS_RB = 216 * MiB;
constexpr size_t WS_Y = 282 * MiB;
constexpr size_t WS_XPRE = 362 * MiB;
constexpr size_t WS_X8 = 394 * MiB;
constexpr size_t WS_K8 = 410 * MiB;
constexpr size_t WS_MOEW2 = 426 * MiB;
constexpr size_t WS_RTW = 3 * MiB + 512 * KiB;
constexpr size_t WS_LIST = 474 * MiB;
constexpr size_t WS_END = 476 * MiB;
constexpr size_t RA_QKV = 0, RA_O_DIFF = 0, RA_Q = 0, RA_O_MLA = 48 * MiB, RA_QA = 80 * MiB, RA_CKV = 92 * MiB, RA_XS = 0, RA_H = 80 * MiB;
constexpr size_t RB_OD = 0, RB_KV = 0, RB_KROPE = 64 * MiB;

constexpr int LDS_MAIN = 133120;
constexpr int MISC_OFF = LDS_MAIN;
constexpr int LDS_BYTES = LDS_MAIN + 4096;
constexpr int MO_CNT = 64, MO_WBASE = 192, MO_PBASE = 320, MO_NE = 512, MO_UTAB = 640, MO_PE = 1024, MO_PRANK = 1536, MO_PGATE = 2048;
constexpr int CW_GCOUNT = 8192;

#define LDS_WAIT() asm volatile("s_waitcnt lgkmcnt(0)" ::: "memory")
#define VM_WAIT() asm volatile("s_waitcnt vmcnt(0)" ::: "memory")
typedef __bf16 cv_bf16x2 __attribute__((ext_vector_type(2)));
typedef float cv_f32x2 __attribute__((ext_vector_type(2)));
__device__ __forceinline__ unsigned cvtpk(float lo, float hi) { const cv_f32x2 v = {lo, hi}; return __builtin_bit_cast(unsigned, __builtin_convertvector(v, cv_bf16x2)); }
__device__ __forceinline__ float bf_lo(unsigned w) { return __uint_as_float(w << 16); }
__device__ __forceinline__ float bf_hi(unsigned w) { return __uint_as_float(w & 0xffff0000u); }
__device__ __forceinline__ float shx(float v, int m, int lane) { return __int_as_float(__builtin_amdgcn_ds_bpermute((lane ^ m) << 2, __float_as_int(v))); }
__device__ __forceinline__ int shxi(int v, int m, int lane) { return __builtin_amdgcn_ds_bpermute((lane ^ m) << 2, v); }
__device__ __forceinline__ float shi(float v, int src) { return __int_as_float(__builtin_amdgcn_ds_bpermute(src << 2, __float_as_int(v))); }
template <int CTRL> __device__ __forceinline__ float dppf(float v) { return __int_as_float(__builtin_amdgcn_update_dpp(0, __float_as_int(v), CTRL, 0xf, 0xf, false)); }
template <int CTRL> __device__ __forceinline__ int dppi(int v) { return __builtin_amdgcn_update_dpp(0, v, CTRL, 0xf, 0xf, false); }
__device__ __forceinline__ float wave_sum(float v, int) {
    v += dppf<0xB1>(v); v += dppf<0x4E>(v); v += dppf<0x141>(v); v += dppf<0x140>(v);
    { auto r = __builtin_amdgcn_permlane16_swap(__float_as_uint(v), __float_as_uint(v), false, false); v = __uint_as_float(r[0]) + __uint_as_float(r[1]); }
    { auto r = __builtin_amdgcn_permlane32_swap(__float_as_uint(v), __float_as_uint(v), false, false); v = __uint_as_float(r[0]) + __uint_as_float(r[1]); }
    return v;
}

#define XB_TMO      128
#define XB_XCNT(j)  (256  + 64 * (j))
#define XB_XSUB(j)  (1280 + 64 * (j))
#define XB_XGEN(j)  (2304 + 64 * (j))
#define XB_TOP      3328
#define XB_TOPGEN   3392
#define XCD_BAR_WORDS 3456
#define XB_SPIN_CAP (1u << 18)

__device__ __forceinline__ unsigned xb_ld(unsigned* p)              { return __hip_atomic_load(p, __ATOMIC_RELAXED, __HIP_MEMORY_SCOPE_AGENT); }
__device__ __forceinline__ unsigned xb_add(unsigned* p, unsigned v) { return __hip_atomic_fetch_add(p, v, __ATOMIC_RELAXED, __HIP_MEMORY_SCOPE_AGENT); }
__device__ __forceinline__ unsigned xb_xcc_id() { return (unsigned)__builtin_amdgcn_s_getreg((3 << 11) | 20) & 0xFu; }
#define XB_SPIN(cond, bar) do { unsigned _sp = 0; while (cond) { __builtin_amdgcn_s_sleep(1); \
    if ((++_sp & 255u) == 0u) { if (xb_ld(&(bar)[XB_TMO])) break; if (_sp > XB_SPIN_CAP) { atomicAdd(&(bar)[XB_TMO], 1u); break; } } } } while (0)

struct XcdBarrier {
    unsigned* bar; unsigned x;
    volatile LAS unsigned* st;
};
__device__ __forceinline__ XcdBarrier xcd_barrier_post(unsigned* bar, volatile LAS unsigned* st, int wv) {
    XcdBarrier b; b.bar = bar; b.x = xb_xcc_id(); b.st = st;
    if (mk_tid(wv) == 0) (void)xb_add(&bar[XB_XCNT(b.x)], 1u);
    return b;
}
__device__ __forceinline__ void xcd_barrier_complete(unsigned* bar, unsigned x, unsigned& nloc, unsigned& nx) {
    const unsigned G = gridDim.x * gridDim.y * gridDim.z;
    unsigned sum, cnt, mine, sp = 0u;
    for (;;) {
        sum = 0u; cnt = 0u; mine = 0u;
#pragma unroll
        for (unsigned j = 0; j < 16; ++j) { const unsigned c = xb_ld(&bar[XB_XCNT(j)]); sum += c; cnt += (c > 0u) ? 1u : 0u; mine = (j == x) ? c : mine; }
        if (sum == G) break;
        __builtin_amdgcn_s_sleep(1);
        if ((++sp & 255u) == 0u) { if (xb_ld(&bar[XB_TMO])) break; if (sp > XB_SPIN_CAP) { atomicAdd(&bar[XB_TMO], 1u); break; } }
    }
    nloc = mine > 0u ? mine : 1u; nx = cnt > 0u ? cnt : 1u;
}
__device__ __forceinline__ void xcd_barrier(const XcdBarrier& b, int wv) {
    asm volatile("s_waitcnt vmcnt(0)" ::: "memory");
    __syncthreads();
    if (mk_tid(wv) == 0) {
        unsigned* bar = b.bar; asm volatile("" : "+s"(bar));
        __builtin_amdgcn_s_waitcnt(0);
        unsigned nloc = b.st[0], nx = b.st[1];
        if (nloc == 0u) { xcd_barrier_complete(bar, b.x, nloc, nx); b.st[0] = nloc; b.st[1] = nx; }
        const unsigned old = xb_add(&bar[XB_XSUB(b.x)], 1u);
        const unsigned gen = old / nloc;
        if (old + 1u == (gen + 1u) * nloc) {
            __builtin_amdgcn_fence(__ATOMIC_RELEASE, "agent");
            asm volatile("s_waitcnt vmcnt(0)" ::: "memory");
            const unsigned og = xb_add(&bar[XB_TOP], 1u);
            const unsigned tg = og / nx;
            if (og + 1u == (tg + 1u) * nx) xb_add(&bar[XB_TOPGEN], 1u);
            else XB_SPIN(xb_ld(&bar[XB_TOPGEN]) == tg, bar);
            __builtin_amdgcn_fence(__ATOMIC_ACQUIRE, "agent");
            xb_add(&bar[XB_XGEN(b.x)], 1u);
            asm volatile("s_waitcnt vmcnt(0)" ::: "memory");
        } else {
            XB_SPIN(xb_ld(&bar[XB_XGEN(b.x)]) == gen, bar);
            __builtin_amdgcn_fence(__ATOMIC_ACQUIRE, "agent");
            asm volatile("s_waitcnt vmcnt(0)" ::: "memory");
        }
    }
    __syncthreads();
}

typedef const f32x4 (&AccRef)[2][2][4][2];
#define EPI_LANE() const int t_ = mk_lane(); const int fr = t_ & 15, fq = (t_ >> 4) & 3

__device__ __forceinline__ void moe_table(const unsigned* gcount, LAS int* pbase, LAS int* ne, int wave, int lane) {
    if (wave == 0) {
        const int n = (lane < 32) ? (int)__hip_atomic_load(gcount + (lane & 31), __ATOMIC_RELAXED, __HIP_MEMORY_SCOPE_AGENT) : 0;
        const int np = (n + 255) >> 8; int incl = np;
#pragma unroll
        for (int d = 1; d < 32; d <<= 1) { const int t = __builtin_amdgcn_ds_bpermute(((lane - d) & 63) << 2, incl); if (lane >= d) incl += t; }
        if (lane < 32) { pbase[lane] = incl - np; ne[lane] = n; }
        if (lane == 31) pbase[32] = incl;
    }
}
constexpr int MOE_MAXU = 8;
template <int NTL> __device__ __forceinline__ void moe_units(const LAS int* pbase, LAS int* utab, int G, int c, int wave, int lane) {
    if (wave == 0) {
        const int nunits = pbase[32] * NTL; int cnt = 0;
        for (int i = 0; i < MOE_MAXU; ++i) { const int L = i * G + c; if (L >= nunits) break;
            const int pm = L / NTL, t = L % NTL;
            const int e = __builtin_popcountll(__builtin_amdgcn_ballot_w64(lane >= 1 && lane < 32 && pbase[lane & 31] <= pm));
            if (lane == 0) { utab[2 * i] = pm; utab[2 * i + 1] = e * NTL + t; } ++cnt; }
        if (lane == 0) utab[2 * MOE_MAXU] = cnt;
    }
}
template <int NTL, bool GATH> struct MoeOrd {
    static constexpr bool GATHER = GATH;
    const LAS int* pbase; const LAS int* ne; const LAS int* utab; const int* list; int nmine;
    __device__ void init(const LAS int* pb, const LAS int* n, const LAS int* ut, const int* l) { pbase = pb; ne = n; utab = ut; list = l; nmine = __builtin_amdgcn_readfirstlane(ut[2 * MOE_MAXU]); }
    __device__ __forceinline__ bool next(int i, pg8::Unit& u) const {
        if (i >= nmine) return false;
        u.pm = __builtin_amdgcn_readfirstlane(utab[2 * i]); u.pn = __builtin_amdgcn_readfirstlane(utab[2 * i + 1]); return true;
    }
    __device__ __forceinline__ unsigned row_off(const pg8::Unit& u, int r) const {
        const int e = u.pn / NTL, n = ne[e]; int idx = (u.pm - pbase[e]) * 256 + r; idx = idx < n ? idx : n - 1;
        return (unsigned)list[e * T + idx] * (unsigned)(D * MOE_ES);
    }
    __device__ __forceinline__ void a_ready(const pg8::Unit&) const {}
    __device__ __forceinline__ void done(const pg8::Unit&) const {}
};

__device__ __forceinline__ u32x4 pack8(const f32x4 v0, const f32x4 v1) { u32x4 w; w.x = cvtpk(v0[0], v0[1]); w.y = cvtpk(v0[2], v0[3]); w.z = cvtpk(v1[0], v1[1]); w.w = cvtpk(v1[2], v1[3]); return w; }
__device__ __forceinline__ float f8clamp(float v) { return __builtin_amdgcn_fmed3f(v, -448.0f, 448.0f); }
__device__ __forceinline__ u32x2 pack8_f8(const f32x4 v0, const f32x4 v1) { int a = 0, b = 0;
    a = __builtin_amdgcn_cvt_pk_fp8_f32(v0[0], v0[1], a, false); a = __builtin_amdgcn_cvt_pk_fp8_f32(v0[2], v0[3], a, true);
    b = __builtin_amdgcn_cvt_pk_fp8_f32(v1[0], v1[1], b, false); b = __builtin_amdgcn_cvt_pk_fp8_f32(v1[2], v1[3], b, true); u32x2 w; w.x = (unsigned)a; w.y = (unsigned)b; return w; }
__device__ __forceinline__ f32x4 f8clamp4(const f32x4 v) { f32x4 r; r[0] = f8clamp(v[0]); r[1] = f8clamp(v[1]); r[2] = f8clamp(v[2]); r[3] = f8clamp(v[3]); return r; }

struct EpiStore {
    static constexpr bool PERM = true, AFTER_DRAIN = false;
    bf16* O; int ldc;
    __device__ __forceinline__ void operator()(AccRef acc, const pg8::Unit& u, int wr, int wc, int, int) const {
        EPI_LANE();
        const int row0 = u.pm * 256 + wr * 64 + fr, col0 = u.pn * 256 + wc * 32 + 8 * fq;
#pragma unroll
        for (int ai = 0; ai < 2; ++ai)
#pragma unroll
            for (int m = 0; m < 4; ++m) { bf16* rowp = O + (size_t)(row0 + ai * 128 + m * 16) * ldc + col0;
#pragma unroll
                for (int bj = 0; bj < 2; ++bj) *(u32x4*)(rowp + bj * 128) = pack8(acc[ai][bj][m][0], acc[ai][bj][m][1]); }
    }
};
struct EpiRes {
    static constexpr bool PERM = true, AFTER_DRAIN = false;
    const float* res32; const bf16* res16; bf16* out; float sc;
    __device__ __forceinline__ void operator()(AccRef acc, const pg8::Unit& u, int wr, int wc, int, int) const {
        EPI_LANE();
        const int row0 = u.pm * 256 + wr * 64 + fr, col0 = u.pn * 256 + wc * 32 + 8 * fq;
#pragma unroll
        for (int ai = 0; ai < 2; ++ai) {
            f32x4 r0[4][2], r1[4][2];
#pragma unroll
            for (int m = 0; m < 4; ++m) { const size_t off = (size_t)(row0 + ai * 128 + m * 16) * D + col0;
#pragma unroll
                for (int bj = 0; bj < 2; ++bj) {
                    if (res32) { r0[m][bj] = *(const f32x4*)(res32 + off + bj * 128); r1[m][bj] = *(const f32x4*)(res32 + off + bj * 128 + 4); }
                    else { const u32x4 w = *(const u32x4*)(res16 + off + bj * 128); r0[m][bj][0] = bf_lo(w.x); r0[m][bj][1] = bf_hi(w.x); r0[m][bj][2] = bf_lo(w.y); r0[m][bj][3] = bf_hi(w.y);
                           r1[m][bj][0] = bf_lo(w.z); r1[m][bj][1] = bf_hi(w.z); r1[m][bj][2] = bf_lo(w.w); r1[m][bj][3] = bf_hi(w.w); } } }
#pragma unroll
            for (int m = 0; m < 4; ++m) { const size_t off = (size_t)(row0 + ai * 128 + m * 16) * D + col0;
#pragma unroll
                for (int bj = 0; bj < 2; ++bj) *(u32x4*)(out + off + bj * 128) = pack8(r0[m][bj] * ALPHA + acc[ai][bj][m][0] * sc, r1[m][bj] * ALPHA + acc[ai][bj][m][1] * sc); }
            asm volatile("" ::: "memory"); }
    }
};
__device__ __forceinline__ void rope8(f32x4& v0, f32x4& v1, const f32x4 c, const f32x4 s) {
    float a, b;
    a = v0[0]; b = v0[1]; v0[0] = a * c[0] - b * s[0]; v0[1] = b * c[0] + a * s[0];
    a = v0[2]; b = v0[3]; v0[2] = a * c[1] - b * s[1]; v0[3] = b * c[1] + a * s[1];
    a = v1[0]; b = v1[1]; v1[0] = a * c[2] - b * s[2]; v1[1] = b * c[2] + a * s[2];
    a = v1[2]; b = v1[3]; v1[2] = a * c[3] - b * s[3]; v1[3] = b * c[3] + a * s[3];
}
struct EpiMlaA {
    static constexpr bool PERM = true, AFTER_DRAIN = false;
    bf16* qa; unsigned char* ckv8; bf16* krope; float* ssq_q; float* ssq_kv; const float* cosT; const float* sinT; float sc;
    __device__ __forceinline__ void operator()(AccRef acc, const pg8::Unit& u, int wr, int wc, int, int) const {
        EPI_LANE();
        const int row0 = u.pm * 256 + wr * 64 + fr, c8 = wc * 32 + 8 * fq;
        if (u.pn <= 2) {
            const int cbase = (u.pn == 1) ? 256 : 0, nbj = (u.pn == 1) ? 1 : 2;
            float* sp = (u.pn == 2) ? ssq_kv : ssq_q; const int sstr = (u.pn == 2) ? 4 : 8, sidx = (u.pn == 1) ? 4 + wc : wc;
#pragma unroll
            for (int ai = 0; ai < 2; ++ai)
#pragma unroll
                for (int m = 0; m < 4; ++m) { const int row = row0 + ai * 128 + m * 16; float s = 0.f;
#pragma unroll
                    for (int bj = 0; bj < 2; ++bj) if (bj < nbj) { const f32x4 v0 = acc[ai][bj][m][0] * sc, v1 = acc[ai][bj][m][1] * sc;
                        s += (v0[0] * v0[0] + v0[1] * v0[1]) + (v0[2] * v0[2] + v0[3] * v0[3]) + (v1[0] * v1[0] + v1[1] * v1[1]) + (v1[2] * v1[2] + v1[3] * v1[3]);
                        if (u.pn == 2) *(u32x2*)(ckv8 + (size_t)row * 256 + bj * 128 + c8) = pack8_f8(v0, v1);
                        else *(u32x4*)(qa + (size_t)row * 384 + cbase + bj * 128 + c8) = pack8(v0, v1); }
                    { auto r_ = __builtin_amdgcn_permlane16_swap(__float_as_uint(s), __float_as_uint(s), false, false); s = __uint_as_float(r_[0]) + __uint_as_float(r_[1]); }
                    { auto r_ = __builtin_amdgcn_permlane32_swap(__float_as_uint(s), __float_as_uint(s), false, false); s = __uint_as_float(r_[0]) + __uint_as_float(r_[1]); }
                    if (fq == 0) sp[(size_t)row * sstr + sidx] = s; }
        } else if (wc < 2) {
#pragma unroll
            for (int ai = 0; ai < 2; ++ai)
#pragma unroll
                for (int m = 0; m < 4; ++m) { const int row = row0 + ai * 128 + m * 16, pos = row & (SEQ - 1);
                    f32x4 v0 = acc[ai][0][m][0] * sc, v1 = acc[ai][0][m][1] * sc;
                    const f32x4 c = *(const f32x4*)(cosT + pos * 32 + (c8 >> 1)), s = *(const f32x4*)(sinT + pos * 32 + (c8 >> 1));
                    rope8(v0, v1, c, s);
                    *(u32x2*)((unsigned char*)krope + (size_t)row * 64 + c8) = pack8_f8(v0 * K8_SCALE, v1 * K8_SCALE); }
        }
    }
};
struct EpiQB {
    static constexpr bool PERM = true, AFTER_DRAIN = false;
    bf16* q; const float* ssq_q; const float* cosT; const float* sinT; float qscale;
    __device__ __forceinline__ void operator()(AccRef acc, const pg8::Unit& u, int wr, int wc, int, int) const {
        EPI_LANE();
        const int row0 = u.pm * 256 + wr * 64 + fr, c8 = wc * 32 + 8 * fq;
#pragma unroll
        for (int ai = 0; ai < 2; ++ai)
#pragma unroll
            for (int m = 0; m < 4; ++m) { const int row = row0 + ai * 128 + m * 16, pos = row & (SEQ - 1);
                const f32x4 pa = *(const f32x4*)(ssq_q + (size_t)row * 8), pb = *(const f32x4*)(ssq_q + (size_t)row * 8 + 4);
                const float ss = ((pa[0] + pa[1]) + (pa[2] + pa[3])) + ((pb[0] + pb[1]) + (pb[2] + pb[3]));
                const float rs = qscale / sqrtf(ss * (1.0f / 384.0f) + LN_EPS);
#pragma unroll
                for (int bj = 0; bj < 2; ++bj) { const int col = u.pn * 256 + bj * 128 + c8, head = col / 192, within = col - head * 192;
                    f32x4 v0 = acc[ai][bj][m][0] * rs, v1 = acc[ai][bj][m][1] * rs;
                    if (within >= 128) { const int i0 = (within - 128) >> 1;
                        const f32x4 c = *(const f32x4*)(cosT + pos * 32 + i0), s = *(const f32x4*)(sinT + pos * 32 + i0); rope8(v0, v1, c, s); }
                    *(u32x2*)((unsigned char*)q + (size_t)row * 1536 + col) = pack8_f8(v0, v1); } }
    }
};
struct EpiKVB {
    static constexpr bool PERM = true, AFTER_DRAIN = false;
    bf16* kv; unsigned char* k8; const float* ssq_kv; float sc;
    __device__ __forceinline__ void operator()(AccRef acc, const pg8::Unit& u, int wr, int wc, int, int) const {
        EPI_LANE();
        const int row0 = u.pm * 256 + wr * 64 + fr, col0 = u.pn * 256 + wc * 32 + 8 * fq;
#pragma unroll
        for (int ai = 0; ai < 2; ++ai)
#pragma unroll
            for (int m = 0; m < 4; ++m) { const int row = row0 + ai * 128 + m * 16;
                const f32x4 pa = *(const f32x4*)(ssq_kv + (size_t)row * 4);
                const float rs = sc / sqrtf(((pa[0] + pa[1]) + (pa[2] + pa[3])) * (1.0f / 256.0f) + LN_EPS);
                *(u32x2*)(k8 + (size_t)row * 1024 + u.pn * 128 + wc * 32 + 8 * fq) = pack8_f8(acc[ai][0][m][0] * (rs * K8_SCALE), acc[ai][0][m][1] * (rs * K8_SCALE));
                *(u32x4*)(kv + (size_t)row * 2048 + col0 + 128) = pack8(acc[ai][1][m][0] * rs, acc[ai][1][m][1] * rs); }
    }
};
__device__ __forceinline__ float silu_mul(float g, float u) { return g * u / (1.0f + __builtin_amdgcn_exp2f(-g * LOG2E)); }
struct EpiUp {
    static constexpr bool PERM = true, AFTER_DRAIN = false;
    bf16* h; float sc;
    __device__ __forceinline__ void operator()(AccRef acc, const pg8::Unit& u, int wr, int wc, int, int) const {
        EPI_LANE();
        const int row0 = u.pm * 256 + wr * 64 + fr, col0 = (u.pn & 1) * 128 + wc * 32 + 8 * fq;
#pragma unroll
        for (int ai = 0; ai < 2; ++ai)
#pragma unroll
            for (int m = 0; m < 4; ++m) { f32x4 v0, v1;
#pragma unroll
                for (int i = 0; i < 4; ++i) { v0[i] = silu_mul(acc[ai][0][m][0][i] * sc, acc[ai][1][m][0][i] * sc); v1[i] = silu_mul(acc[ai][0][m][1][i] * sc, acc[ai][1][m][1][i] * sc); }
                if constexpr (MOE_F8) {
#pragma unroll
                    for (int i = 0; i < 4; ++i) { v0[i] = f8clamp(v0[i] * H_SCALE); v1[i] = f8clamp(v1[i] * H_SCALE); }
                    *(u32x2*)((unsigned char*)h + (size_t)(row0 + ai * 128 + m * 16) * FFE + col0) = pack8_f8(v0, v1); }
                else *(u32x4*)(h + (size_t)(row0 + ai * 128 + m * 16) * FFE + col0) = pack8(v0, v1); }
    }
};
struct EpiDown {
    static constexpr bool PERM = true, AFTER_DRAIN = false;
    bf16* y; float sc;
    __device__ __forceinline__ void operator()(AccRef acc, const pg8::Unit& u, int wr, int wc, int, int) const {
        EPI_LANE();
        const int row0 = u.pm * 256 + wr * 64 + fr, col0 = (u.pn & 3) * 256 + wc * 32 + 8 * fq;
#pragma unroll
        for (int ai = 0; ai < 2; ++ai)
#pragma unroll
            for (int m = 0; m < 4; ++m) { const int row = row0 + ai * 128 + m * 16;
#pragma unroll
                for (int bj = 0; bj < 2; ++bj) { if constexpr (Y_F8) *(u32x2*)((unsigned char*)y + (size_t)row * D + col0 + bj * 128) = pack8_f8(f8clamp4(acc[ai][bj][m][0] * sc), f8clamp4(acc[ai][bj][m][1] * sc));
                    else *(u32x4*)(y + (size_t)row * D + col0 + bj * 128) = pack8(acc[ai][bj][m][0] * sc, acc[ai][bj][m][1] * sc); }
                asm volatile("" ::: "memory"); }
    }
};

namespace att {
constexpr float O8_SCALE = 16.0f;
__device__ __forceinline__ int crow(int r, int hi) { return (r & 3) + 8 * (r >> 2) + 4 * hi; }
__device__ __forceinline__ int v_st(int k, int c) { const int kk = k; return ((kk >> 3) * 4 + (c >> 5)) * 512 + ((kk & 7) * 32 + (c & 31)) * 2; }
__device__ __forceinline__ int v_rd_base(int lane) { return ((lane & 3) << 3) | (((lane >> 2) & 3) << 6) | (((lane >> 4) & 1) << 5) | (((lane >> 5) & 1) << 8); }
constexpr int v_rd_off(int d0, int ks, int half) { return d0 * 512 + ks * 4096 + half * 2048; }
template <int OFF> __device__ __forceinline__ s16x4 tr_read(unsigned vb) {
    s16x4 r; asm volatile("ds_read_b64_tr_b16 %0, %1 offset:%2" : "=&v"(r) : "v"(vb), "i"(OFF) : "memory"); return r;
}
struct VFrag { s16x4 l0, h0, l1, h1, l2, h2, l3, h3; };
template <int D0> __device__ __forceinline__ void v_read(VFrag& f, unsigned vb) {
    f.l0 = tr_read<v_rd_off(D0, 0, 0)>(vb); f.h0 = tr_read<v_rd_off(D0, 0, 1)>(vb); f.l1 = tr_read<v_rd_off(D0, 1, 0)>(vb); f.h1 = tr_read<v_rd_off(D0, 1, 1)>(vb);
    f.l2 = tr_read<v_rd_off(D0, 2, 0)>(vb); f.h2 = tr_read<v_rd_off(D0, 2, 1)>(vb); f.l3 = tr_read<v_rd_off(D0, 3, 0)>(vb); f.h3 = tr_read<v_rd_off(D0, 3, 1)>(vb);
}
__device__ __forceinline__ void pv_mma(f32x16& od, const VFrag& f, bf16x8 pa0, bf16x8 pa1, bf16x8 pa2, bf16x8 pa3) {
#define ATT_PK(L, H) (bf16x8){L[0], L[1], L[2], L[3], H[0], H[1], H[2], H[3]}
    od = __builtin_amdgcn_mfma_f32_32x32x16_bf16(pa0, ATT_PK(f.l0, f.h0), od, 0, 0, 0);
    od = __builtin_amdgcn_mfma_f32_32x32x16_bf16(pa1, ATT_PK(f.l1, f.h1), od, 0, 0, 0);
    od = __builtin_amdgcn_mfma_f32_32x32x16_bf16(pa2, ATT_PK(f.l2, f.h2), od, 0, 0, 0);
    od = __builtin_amdgcn_mfma_f32_32x32x16_bf16(pa3, ATT_PK(f.l3, f.h3), od, 0, 0, 0);
#undef ATT_PK
}
template <int S> __device__ __forceinline__ void v_read_s(VFrag& f, unsigned vb) {
    f.l0 = tr_read<v_rd_off(0, S, 0)>(vb); f.h0 = tr_read<v_rd_off(0, S, 1)>(vb); f.l1 = tr_read<v_rd_off(1, S, 0)>(vb); f.h1 = tr_read<v_rd_off(1, S, 1)>(vb);
    f.l2 = tr_read<v_rd_off(2, S, 0)>(vb); f.h2 = tr_read<v_rd_off(2, S, 1)>(vb); f.l3 = tr_read<v_rd_off(3, S, 0)>(vb); f.h3 = tr_read<v_rd_off(3, S, 1)>(vb);
}
__device__ __forceinline__ void pv_all(f32x16 (&o)[4], unsigned vb, bf16x8 pa0, bf16x8 pa1, bf16x8 pa2, bf16x8 pa3) {
    VFrag fa, fb;
    v_read<0>(fa, vb); v_read<1>(fb, vb);
    asm volatile("s_waitcnt lgkmcnt(8)" ::: "memory"); __builtin_amdgcn_sched_barrier(0);
    pv_mma(o[0], fa, pa0, pa1, pa2, pa3); __builtin_amdgcn_sched_barrier(0);
    v_read<2>(fa, vb);
    asm volatile("s_waitcnt lgkmcnt(8)" ::: "memory"); __builtin_amdgcn_sched_barrier(0);
    pv_mma(o[1], fb, pa0, pa1, pa2, pa3); __builtin_amdgcn_sched_barrier(0);
    v_read<3>(fb, vb);
    asm volatile("s_waitcnt lgkmcnt(8)" ::: "memory"); __builtin_amdgcn_sched_barrier(0);
    pv_mma(o[2], fa, pa0, pa1, pa2, pa3); __builtin_amdgcn_sched_barrier(0);
    asm volatile("s_waitcnt lgkmcnt(0)" ::: "memory"); __builtin_amdgcn_sched_barrier(0);
    pv_mma(o[3], fb, pa0, pa1, pa2, pa3);
}
template <int DQK> __device__ __forceinline__ int k_off(int row, int c) { return row * (DQK * 2) + (((c & ~7) | ((c ^ (row >> 1)) & 7)) << 4); }

#define ATT_PK4(P, BASE, OUT) do { unsigned a0 = cvtpk(P[BASE + 0], P[BASE + 1]), a1 = cvtpk(P[BASE + 2], P[BASE + 3]);   \
    unsigned b0_ = cvtpk(P[BASE + 4], P[BASE + 5]), b1_ = cvtpk(P[BASE + 6], P[BASE + 7]);                              \
    u32x4 w = {a0, a1, b0_, b1_}; OUT = __builtin_bit_cast(bf16x8, w); } while (0)
__device__ __forceinline__ float sm_halfmax(const f32x16& p0, const f32x16& p1) {
    float pmax = p0[0];
#pragma unroll
    for (int r = 1; r < 16; ++r) pmax = __builtin_elementwise_maximum(pmax, p0[r]);
#pragma unroll
    for (int r = 0; r < 16; ++r) pmax = __builtin_elementwise_maximum(pmax, p1[r]);
    return pmax;
}
__device__ __forceinline__ float sm_fullmax(float hm) { auto rr = __builtin_amdgcn_permlane32_swap(__float_as_uint(hm), __float_as_uint(hm), false, false); return fmaxf(__uint_as_float(rr[0]), __uint_as_float(rr[1])); }
template <int DQK, bool ALIBI, bool OF8 = false, bool K8 = false>
__device__ __forceinline__ void unit3(const bf16* Q, int ldq, const bf16* K1, int ldk1, const bf16* K2, int ldk2, const bf16* V, int ldv,
                                      bf16* O, int ldo, int qb, bool rev, float slope2, int EPI, float lam, LAS unsigned char* lds, int wv) {
    static_assert(!K8 || (DQK == 192 && !ALIBI), "fp8 Q K^T is written for the latent attention");
    constexpr int NCH = DQK / 8, KPT = K8 ? 1 : NCH / 8, KT = K8 ? 64 * DQK : 64 * DQK * 2, VT = 16384, NKS = K8 ? 1 : DQK / 16, KPD = 3;
    constexpr float THR = 6.0f, OFF = -1.0e30f;
    int tid = mk_tid(wv);
    const int wid = __builtin_amdgcn_readfirstlane(tid >> 6), lane = tid & 63, r32 = lane & 31, hi = lane >> 5;
    LAS unsigned char* Kl = lds; LAS unsigned char* Vl = lds + 2 * KT; LAS float* ws = (LAS float*)(lds + 2 * KT + 3 * VT) + wid * 64;
    bf16x8 qr[NKS]; pg8::i32x8 q8[3];
    if constexpr (K8) { const unsigned char* Qb = (const unsigned char*)Q + (size_t)(wid * 32 + r32) * ldq + hi * 32;
#pragma unroll
        for (int kb = 0; kb < 3; ++kb) q8[kb] = pg8::cat8(*(const bf16x8*)(Qb + kb * 64), *(const bf16x8*)(Qb + kb * 64 + 16)); }
    else { const bf16* Qw = Q + (size_t)(wid * 32 + r32) * ldq + hi * 8;
#pragma unroll
      for (int d0 = 0; d0 < NKS; ++d0) qr[d0] = *(const bf16x8*)(Qw + d0 * 16); }
    const int sr = tid >> 4, sc = (tid & 15) * 8, vst0 = v_st(sr, sc), vst1 = v_st(32 + sr, sc);
    const unsigned voff0 = (unsigned)(sr * ldv + sc) * 2u, voff1 = (unsigned)((32 + sr) * ldv + sc) * 2u;
    constexpr int KPN = (DQK > 128) ? 2 : 1, C1 = (DQK > 128) ? 16 : 8;
    unsigned koff[KPT]; int kdst[KPT]; unsigned koff2 = 0u; int kdst2 = 0;
    if constexpr (K8) {
        const int row = tid >> 3, cc = tid & 7, sw = (row >> 2) & 3;
        koff[0] = (unsigned)(row * ldk1 + cc * 16); kdst[0] = (cc >> 2) * 4096 + row * 64 + (((cc & 3) ^ sw) << 4);
        koff2 = (unsigned)(row * ldk2 + cc * 8); kdst2 = 2 * 4096 + row * 64 + (((cc >> 1) ^ sw) << 4) + (cc & 1) * 8;
    } else {
#pragma unroll
    for (int i = 0; i < KPT; ++i) {
        if (i < KPN) { const int idx = tid + 512 * i, row = idx / C1, cc = idx % C1; koff[i] = (unsigned)(row * ldk1 + cc * 8) * 2u; kdst[i] = k_off<DQK>(row, cc); }
        else { const int row = tid >> 3, cc = tid & 7; koff[i] = (unsigned)(row * ldk2 + cc * 8) * 2u; kdst[i] = k_off<DQK>(row, 16 + cc); } } }
    bf16x8 vs0, vs1, ks[KPT]; u32x2 ks2 = {0u, 0u};
#define U3_GLOAD(j) do { const unsigned tv_ = (unsigned)(j) * (unsigned)(64 * 2) * (unsigned)ldv; vs0 = *(const bf16x8*)((const char*)V + (tv_ + voff0)); vs1 = *(const bf16x8*)((const char*)V + (tv_ + voff1)); \
    if constexpr (K8) { ks[0] = *(const bf16x8*)((const char*)K1 + ((unsigned)(j) * 64u * (unsigned)ldk1 + koff[0])); ks2 = *(const u32x2*)((const char*)K2 + ((unsigned)(j) * 64u * (unsigned)ldk2 + koff2)); } \
    else { const unsigned t1_ = (unsigned)(j) * (unsigned)(64 * 2) * (unsigned)ldk1, t2_ = (unsigned)(j) * (unsigned)(64 * 2) * (unsigned)ldk2; \
    _Pragma("unroll") for (int _i = 0; _i < KPT; ++_i) ks[_i] = *(const bf16x8*)((_i < KPN ? (const char*)K1 + (t1_ + koff[_i]) : (const char*)K2 + (t2_ + koff[_i]))); } } while (0)
#define U3_LWRITE(kb, vb) do { *(LAS bf16x8*)(Vl + (vb) * VT + vst0) = vs0; *(LAS bf16x8*)(Vl + (vb) * VT + vst1) = vs1; \
    _Pragma("unroll") for (int _i = 0; _i < KPT; ++_i) *(LAS bf16x8*)(Kl + (kb) * KT + kdst[_i]) = ks[_i]; \
    if constexpr (K8) *(LAS u32x2*)(Kl + (kb) * KT + kdst2) = ks2; } while (0)
    const unsigned vb0 = (unsigned)(size_t)Vl + (unsigned)v_rd_base(lane);
    const int swz = (r32 >> 1) & 7;
    const int kro8 = r32 * 64, kc8a = ((2 * hi) ^ ((r32 >> 2) & 3)) << 4, kc8b = ((2 * hi + 1) ^ ((r32 >> 2) & 3)) << 4;
    f32x16 o[4];
#pragma unroll
    for (int r = 0; r < 16; ++r) {
#pragma unroll
        for (int d = 0; d < 4; ++d) o[d][r] = 0.f; }
    float m_cur = 0.f, l_reg = 0.f;
    bf16x8 pa0, pa1, pa2, pa3;
    const int NT = 4 * qb + 4, jmax = 4 * qb + (wid >> 1), qpos = qb * 256 + wid * 32 + r32;
    const int jstep = rev ? -1 : 1, jfirst = rev ? NT - 1 : 0;
    const int act_lo = rev ? NT - 1 - jmax : 0; const unsigned act_span = rev ? (unsigned)(NT - act_lo) : (unsigned)(jmax + 1);
    bf16x8 kx0 = {0, 0, 0, 0, 0, 0, 0, 0}, kx1 = kx0; unsigned sw0 = 0u;
    if (ALIBI) { const unsigned one1 = 0x3F80u, k0b = cvtpk((float)r32, (float)r32), k1b = cvtpk((float)(32 + r32), (float)(32 + r32));
        const u32x4 a = {hi ? 0u : k0b, hi ? 0u : (one1 | (one1 << 16)), hi ? 0u : one1, 0u}, b = {hi ? 0u : k1b, hi ? 0u : (one1 | (one1 << 16)), hi ? 0u : one1, 0u};
        kx0 = __builtin_bit_cast(bf16x8, a); kx1 = __builtin_bit_cast(bf16x8, b);
        const unsigned sh = cvtpk(slope2, 0.f) & 0xffffu; const float sl = slope2 - __uint_as_float(sh << 16); sw0 = sh | (cvtpk(sl, 0.f) << 16); }
#define U3_QK(j, kb) do { const float bnd_ = ((j) > jmax) ? OFF : -m_cur; \
    if (ALIBI) { const float base = ((j) > jmax) ? OFF : fmaf(-slope2, (float)(qpos - 64 * (j)), -m_cur); \
          \
        const unsigned bh = cvtpk(base, 0.f) & 0xffffu; const float r1 = base - __uint_as_float(bh << 16); \
        const unsigned bm = cvtpk(r1, 0.f) << 16; \
        const u32x4 qw = {hi ? 0u : sw0, hi ? 0u : (bh | bm), 0u, 0u}; const bf16x8 qx = __builtin_bit_cast(bf16x8, qw); \
        f32x16 z; _Pragma("unroll") for (int r = 0; r < 16; ++r) z[r] = 0.f; \
        p0 = __builtin_amdgcn_mfma_f32_32x32x16_bf16(kx0, qx, z, 0, 0, 0); p1 = __builtin_amdgcn_mfma_f32_32x32x16_bf16(kx1, qx, z, 0, 0, 0); \
    } else { _Pragma("unroll") for (int r = 0; r < 16; ++r) { p0[r] = bnd_; p1[r] = bnd_; } } \
    const LAS unsigned char* Kc = Kl + (kb) * KT; \
    if constexpr (K8) { pg8::i32x8 ka0[3], ka1[3]; \
        U3_KREAD8(0); U3_KREAD8(1); \
        _Pragma("unroll") for (int b_ = 0; b_ < 3; ++b_) { if (b_ == 0) U3_KREAD8(2); __builtin_amdgcn_sched_barrier(0); \
            p0 = __builtin_amdgcn_mfma_scale_f32_32x32x64_f8f6f4(ka0[b_], q8[b_], p0, 0, 0, 0, 0, 0, 0); p1 = __builtin_amdgcn_mfma_scale_f32_32x32x64_f8f6f4(ka1[b_], q8[b_], p1, 0, 0, 0, 0, 0, 0); __builtin_amdgcn_sched_barrier(0); } \
    } else { bf16x8 kb0[NKS], kb1[NKS]; \
    _Pragma("unroll") for (int d0 = 0; d0 < KPD; ++d0) U3_KREAD(d0); \
    _Pragma("unroll") for (int d0 = 0; d0 < NKS; ++d0) { if (d0 + KPD < NKS) U3_KREAD(d0 + KPD); __builtin_amdgcn_sched_barrier(0); \
        p0 = __builtin_amdgcn_mfma_f32_32x32x16_bf16(kb0[d0], qr[d0], p0, 0, 0, 0); p1 = __builtin_amdgcn_mfma_f32_32x32x16_bf16(kb1[d0], qr[d0], p1, 0, 0, 0); __builtin_amdgcn_sched_barrier(0); } } \
    if (ALIBI && (j) == jmax) { asm volatile("; diagonal tile" ::: "memory"); const float s2 = 2.f * slope2; float dk = (float)(qpos - 64 * (j) - 4 * hi), dk1 = (float)(qpos - 64 * (j) - 4 * hi - 32); \
          \
        _Pragma("unroll") for (int r = 0; r < 16; ++r) { p0[r] = fmaf(s2, fminf(dk, 0.f), p0[r]); p1[r] = fmaf(s2, fminf(dk1, 0.f), p1[r]); \
            if ((r & 3) == 3) { dk = (dk + 4.0f) - 4.0f - 1.0f - 4.0f; dk1 = (dk1 + 4.0f) - 4.0f - 1.0f - 4.0f; } else { dk -= 1.0f; dk1 -= 1.0f; } } } \
    pmax = sm_halfmax(p0, p1); } while (0)
#define U3_KREAD8(b) do { const LAS unsigned char* kp_ = Kc + (b) * 4096 + kro8; \
    ka0[b] = pg8::cat8(*(const LAS bf16x8*)(kp_ + kc8a), *(const LAS bf16x8*)(kp_ + kc8b)); ka1[b] = pg8::cat8(*(const LAS bf16x8*)(kp_ + 2048 + kc8a), *(const LAS bf16x8*)(kp_ + 2048 + kc8b)); } while (0)
#define U3_KREAD(d0) do { const int c_ = (d0) * 2 + hi, cs_ = ((c_ & ~7) | ((c_ ^ swz) & 7)) << 4; const LAS unsigned char* kp_ = Kc + r32 * (DQK * 2) + cs_; \
    kb0[d0] = *(const LAS bf16x8*)kp_; kb1[d0] = *(const LAS bf16x8*)(kp_ + 32 * (DQK * 2)); } while (0)
#define U3_EXPADD(e) do { if ((e) < 16) { p0[(e) & 15] = __builtin_amdgcn_exp2f(p0[(e) & 15]); ps_ += p0[(e) & 15]; } else { p1[(e) & 15] = __builtin_amdgcn_exp2f(p1[(e) & 15]); ps_ += p1[(e) & 15]; } } while (0)
#define U3_PKG(g) do { if ((g) == 0) ATT_PK4(p0, 0, pa0); else if ((g) == 1) ATT_PK4(p0, 8, pa1); else if ((g) == 2) ATT_PK4(p1, 0, pa2); else ATT_PK4(p1, 8, pa3); } while (0)
#define U3_CH(k) do { U3_EXPADD(2 * (k)); U3_EXPADD(2 * (k) + 1); if (((k) & 3) == 0 && (k) > 0) U3_PKG((k) / 4 - 1); __builtin_amdgcn_sched_barrier(0); } while (0)
#define U3_PKV(L, H) (bf16x8){L[0], L[1], L[2], L[3], H[0], H[1], H[2], H[3]}
#define U3_SGRP(f, PA, s) do { \
    o[0] = __builtin_amdgcn_mfma_f32_32x32x16_bf16(PA, U3_PKV(f.l0, f.h0), o[0], 0, 0, 0); U3_CH(4 * (s) + 0); \
    o[1] = __builtin_amdgcn_mfma_f32_32x32x16_bf16(PA, U3_PKV(f.l1, f.h1), o[1], 0, 0, 0); U3_CH(4 * (s) + 1); \
    o[2] = __builtin_amdgcn_mfma_f32_32x32x16_bf16(PA, U3_PKV(f.l2, f.h2), o[2], 0, 0, 0); U3_CH(4 * (s) + 2); \
    o[3] = __builtin_amdgcn_mfma_f32_32x32x16_bf16(PA, U3_PKV(f.l3, f.h3), o[3], 0, 0, 0); \
    U3_CH(4 * (s) + 3); } while (0)
#define U3_FINISH() do { float ps_ = 0.f; _Pragma("unroll") for (int k = 0; k < 16; ++k) { U3_EXPADD(2 * k); U3_EXPADD(2 * k + 1); } \
    U3_PKG(0); U3_PKG(1); U3_PKG(2); U3_PKG(3); \
    { auto rr_ = __builtin_amdgcn_permlane32_swap(__float_as_uint(ps_), __float_as_uint(ps_), false, false); l_reg += __uint_as_float(rr_[0]) + __uint_as_float(rr_[1]); } } while (0)
#define U3_SHIFT() do { shifted = __builtin_amdgcn_ballot_w64(pmax > THR) != 0ull; \
    if (shifted) { const float d = fmaxf(sm_fullmax(pmax), 0.f); alpha = __builtin_amdgcn_exp2f(-d); m_cur += d; l_reg *= alpha; \
        _Pragma("unroll") for (int r = 0; r < 16; ++r) { p0[r] -= d; p1[r] -= d; } } } while (0)
#define U3_SYNC() do { asm volatile("s_waitcnt vmcnt(0) lgkmcnt(0)" ::: "memory"); __builtin_amdgcn_s_barrier(); asm volatile("" ::: "memory"); } while (0)

    f32x16 p0, p1; float pmax, alpha = 1.f; bool shifted;
    U3_GLOAD(jfirst); asm volatile("s_waitcnt vmcnt(0)" ::: "memory"); U3_LWRITE(0, 0); U3_SYNC();
    U3_GLOAD(jfirst + jstep);
    U3_QK(jfirst, 0); U3_SHIFT(); U3_FINISH();
    U3_LWRITE(1, 1); U3_SYNC();
    int vprev = 0, vcur = 1;
#pragma unroll 1
    for (int i = 1; i < NT; ++i) {
        const int j = jfirst + jstep * i, kcur = i & 1, vnext = (vcur == 2) ? 0 : vcur + 1;
        if (i + 1 < NT) U3_GLOAD(j + jstep);
        if ((unsigned)(i - act_lo) <= act_span) {
        U3_QK(j, kcur); U3_SHIFT();
        { const unsigned _vb = vb0 + (unsigned)(vprev * VT); float ps_ = 0.f; VFrag fa, fb;
          v_read_s<0>(fa, _vb); v_read_s<1>(fb, _vb); asm volatile("s_waitcnt lgkmcnt(8)" ::: "memory"); __builtin_amdgcn_sched_barrier(0);
          U3_SGRP(fa, pa0, 0);
          v_read_s<2>(fa, _vb); asm volatile("s_waitcnt lgkmcnt(8)" ::: "memory"); __builtin_amdgcn_sched_barrier(0);
          U3_SGRP(fb, pa1, 1);
          v_read_s<3>(fb, _vb); asm volatile("s_waitcnt lgkmcnt(8)" ::: "memory"); __builtin_amdgcn_sched_barrier(0);
          U3_SGRP(fa, pa2, 2);
          asm volatile("s_waitcnt lgkmcnt(0)" ::: "memory"); __builtin_amdgcn_sched_barrier(0);
          U3_SGRP(fb, pa3, 3);
          U3_PKG(3);
          { auto rr_ = __builtin_amdgcn_permlane32_swap(__float_as_uint(ps_), __float_as_uint(ps_), false, false); l_reg += __uint_as_float(rr_[0]) + __uint_as_float(rr_[1]); } }
        if (shifted) {
            if (hi == 0) ws[r32] = alpha;
            LDS_WAIT();
#pragma unroll
            for (int r = 0; r < 16; ++r) { const float a = ws[crow(r, hi)];
#pragma unroll
                for (int dd = 0; dd < 4; ++dd) o[dd][r] *= a; } }
        }
        if (i + 1 < NT) U3_LWRITE(kcur ^ 1, vnext);
        U3_SYNC();
        vprev = vcur; vcur = vnext;
    }
    { const unsigned _vb = vb0 + (unsigned)(vprev * VT); pv_all(o, _vb, pa0, pa1, pa2, pa3); }
    if (hi == 0) ws[32 + r32] = l_reg;
    LDS_WAIT();
    LAS unsigned* Osave = (LAS unsigned*)(lds + 2 * KT + 3 * VT + 2048);
    if (EPI == 1) {
#pragma unroll
        for (int r = 0; r < 16; ++r) { const float rl = __builtin_amdgcn_rcpf(ws[32 + crow(r, hi)]);
            Osave[(r * 2 + 0) * 512 + tid] = cvtpk(o[0][r] * rl, o[1][r] * rl); Osave[(r * 2 + 1) * 512 + tid] = cvtpk(o[2][r] * rl, o[3][r] * rl); }
    } else {
        bf16* Ow = O + (size_t)(wid * 32 + 4 * hi) * ldo + r32;
#pragma unroll
        for (int r = 0; r < 16; ++r) { const float rl = __builtin_amdgcn_rcpf(ws[32 + crow(r, hi)]); bf16* orow = Ow + (size_t)((r & 3) + 8 * (r >> 2)) * ldo;
            float v[4];
#pragma unroll
            for (int d = 0; d < 4; ++d) v[d] = o[d][r] * rl;
            if (EPI == 2) { const unsigned w0 = Osave[(r * 2 + 0) * 512 + tid], w1 = Osave[(r * 2 + 1) * 512 + tid];
                v[0] = bf_lo(w0) - lam * v[0]; v[1] = bf_hi(w0) - lam * v[1]; v[2] = bf_lo(w1) - lam * v[2]; v[3] = bf_hi(w1) - lam * v[3];
                float ss = (v[0] * v[0] + v[1] * v[1]) + (v[2] * v[2] + v[3] * v[3]);
                ss += dppf<0xB1>(ss); ss += dppf<0x4E>(ss); ss += dppf<0x141>(ss); ss += dppf<0x140>(ss);
                { auto r_ = __builtin_amdgcn_permlane16_swap(__float_as_uint(ss), __float_as_uint(ss), false, false); ss = __uint_as_float(r_[0]) + __uint_as_float(r_[1]); }
                const float rn = 1.0f / sqrtf(ss * (1.0f / 128.0f) + LN_EPS);
#pragma unroll
                for (int d = 0; d < 4; ++d) v[d] *= rn; }
            if constexpr (OF8) { unsigned char* orow8 = (unsigned char*)O + (size_t)(wid * 32 + 4 * hi + (r & 3) + 8 * (r >> 2)) * ldo + r32;
#pragma unroll
                for (int d = 0; d < 4; ++d) orow8[d * 32] = (unsigned char)(__builtin_amdgcn_cvt_pk_fp8_f32(__builtin_amdgcn_fmed3f(v[d] * O8_SCALE, -448.0f, 448.0f), 0.f, 0, false) & 0xff); }
            else {
#pragma unroll
                for (int d = 0; d < 4; ++d) orow[d * 32] = (bf16)(cvtpk(v[d], 0.f) & 0xffffu); } }
    }
    asm volatile("s_waitcnt lgkmcnt(0)" ::: "memory"); __builtin_amdgcn_s_barrier(); asm volatile("" ::: "memory");
#undef U3_GLOAD
#undef U3_LWRITE
#undef U3_QK
#undef U3_KREAD
#undef U3_KREAD8
#undef U3_EXPADD
#undef U3_PKG
#undef U3_CH
#undef U3_PKV
#undef U3_SGRP
#undef U3_FINISH
#undef U3_SHIFT
#undef U3_SYNC
}
}

__constant__ float INV_FREQ[32] = {
    1.0f, 0.74989420933245582f, 0.56234132519034908f, 0.42169650342858224f, 0.31622776601683794f, 0.23713737056616552f, 0.17782794100389228f, 0.13335214321633240f,
    0.1f, 0.074989420933245582f, 0.056234132519034908f, 0.042169650342858224f, 0.031622776601683794f, 0.023713737056616552f, 0.017782794100389228f, 0.013335214321633240f,
    0.01f, 0.0074989420933245582f, 0.0056234132519034908f, 0.0042169650342858224f, 0.0031622776601683794f, 0.0023713737056616552f, 0.0017782794100389228f, 0.0013335214321633240f,
    0.001f, 0.00074989420933245582f, 0.00056234132519034908f, 0.00042169650342858224f, 0.00031622776601683794f, 0.00023713737056616552f, 0.00017782794100389228f, 0.00013335214321633240f };

__device__ __forceinline__ void sincos_f64(float ang, float& c_out, float& s_out) {
    const double TWO_PI = 6.283185307179586476925286766559, INV_TWO_PI = 0.15915494309189533576888376337251;
    const double a = (double)ang; const double k = __builtin_rint(a * INV_TWO_PI); double r = (a - k * TWO_PI) * 0.125;
    const double r2 = r * r;
    double s = 1.0 / 6227020800.0; s = s * r2 * -1.0 + 1.0 / 39916800.0; s = -s * r2 + 1.0 / 362880.0; s = -s * r2 + 1.0 / 5040.0; s = -s * r2 + 1.0 / 120.0; s = -s * r2 + 1.0 / 6.0; s = -s * r2 + 1.0; s = s * r;
    double c = 1.0 / 479001600.0; c = -c * r2 + 1.0 / 3628800.0; c = -c * r2 + 1.0 / 40320.0; c = -c * r2 + 1.0 / 720.0; c = -c * r2 + 1.0 / 24.0; c = -c * r2 + 0.5; c = -c * r2 + 1.0;
#pragma unroll
    for (int i = 0; i < 3; ++i) { const double s2 = 2.0 * s * c, c2 = 1.0 - 2.0 * s * s; s = s2; c = c2; }
    c_out = (float)c; s_out = (float)s;
}

template <bool F8 = false>
__device__ __forceinline__ void tr_item(const float* W, int ldw, int k0, int n0, bf16* WT, int ldt, int drow, int dmul,
                                        const float* sk, int smask, float cs, LAS float* scr, int lane) {
    const int kr = lane >> 3, nc = (lane & 7) * 4;
    f32x4 v[8]; float s[8];
#pragma unroll
    for (int i = 0; i < 8; ++i) { v[i] = *(const f32x4*)(W + (size_t)(k0 + kr + 8 * i) * ldw + n0 + nc); s[i] = sk ? cs * sk[(k0 + kr + 8 * i) & smask] : cs; }
#pragma unroll
    for (int i = 0; i < 8; ++i) { LAS float* w = scr + (kr + 8 * i) * 33 + nc; w[0] = v[i][0] * s[i]; w[1] = v[i][1] * s[i]; w[2] = v[i][2] * s[i]; w[3] = v[i][3] * s[i]; }
    LDS_WAIT(); asm volatile("" ::: "memory");
    const int c = lane & 7;
#pragma unroll
    for (int j = 0; j < 4; ++j) { const int n = (lane >> 3) + 8 * j; const LAS float* sp = scr + (8 * c) * 33 + n;
        if constexpr (F8) { const f32x4 a = {sp[0 * 33], sp[1 * 33], sp[2 * 33], sp[3 * 33]}, b = {sp[4 * 33], sp[5 * 33], sp[6 * 33], sp[7 * 33]};
            *(u32x2*)((unsigned char*)WT + (size_t)(drow + n * dmul) * ldt + k0 + 8 * c) = pack8_f8(a, b); }
        else { u32x4 o; o.x = cvtpk(sp[0 * 33], sp[1 * 33]); o.y = cvtpk(sp[2 * 33], sp[3 * 33]); o.z = cvtpk(sp[4 * 33], sp[5 * 33]); o.w = cvtpk(sp[6 * 33], sp[7 * 33]);
            *(u32x4*)(WT + (size_t)(drow + n * dmul) * ldt + k0 + 8 * c) = o; } }
    LDS_WAIT(); asm volatile("" ::: "memory");
}
__device__ __forceinline__ float lambda_init_of(int layer) { return layer == 0 ? 0.2f : 0.35550906759199463f; }

struct Args { const float* in[19]; float* out; unsigned char* ws; int ph_lo, ph_hi; };

__device__ __forceinline__ void phase_prologue(const Args& a, LAS unsigned char* lds, int gw, int NGW, int wave, int lane) {
    LAS float* scr = (LAS float*)(lds + wave * 8448);
    unsigned char* ws = a.ws;
    constexpr int I_QKV = 16 * 96, I_WO = 16 * 32, I_QA = 16 * 12, I_KVA = 16 * 10, I_QB = 6 * 48, I_KVB = 4 * 64;
    constexpr int NITEMS = 2 * I_QKV + 2 * I_WO + 2 * I_QA + I_KVA + 2 * I_QB + I_KVB + 2 * I_WO;
    for (int it = gw; it < NITEMS; it += NGW) {
        int r = it;
        if (r < 2 * I_QKV) { const int L = r / I_QKV; r -= L * I_QKV; const int kb = r / 96, nb = r % 96;
            tr_item(a.in[1] + (size_t)L * 1024 * 3072, 3072, kb * 64, nb * 32, (bf16*)(ws + WS_WQKV) + (size_t)L * 3072 * 1024, 1024, nb * 32, 1, nullptr, 0, nb < 32 ? 0.125f * LOG2E : 1.0f, scr, lane); continue; }
        r -= 2 * I_QKV;
        if (r < 2 * I_WO) { const int L = r / I_WO; r -= L * I_WO; const int kb = r / 32, nb = r % 32;
            tr_item(a.in[4] + (size_t)L * 1024 * 1024, 1024, kb * 64, nb * 32, (bf16*)(ws + WS_WO) + (size_t)L * 1024 * 1024, 1024, nb * 32, 1, a.in[3] + L * 128, 127, 1.0f - lambda_init_of(L), scr, lane); continue; }
        r -= 2 * I_WO;
        if (r < 2 * I_QA) { const int j = r / I_QA; r -= j * I_QA; const int kb = r / 12, nb = r % 12;
            tr_item<true>(a.in[8] + (size_t)j * 1024 * 384, 384, kb * 64, nb * 32, (bf16*)(ws + (j ? WS_WA1 : WS_WA0)), 1024, nb * 32, 1, nullptr, 0, WA_SCALE, scr, lane); continue; }
        r -= 2 * I_QA;
        if (r < I_KVA) { const int kb = r / 10, nb = r % 10;
            if (nb < 8) tr_item<true>(a.in[5], 320, kb * 64, nb * 32, (bf16*)(ws + WS_WA0), 1024, 512 + nb * 32, 1, nullptr, 0, WA_SCALE, scr, lane);
            else        tr_item<true>(a.in[5], 320, kb * 64, nb * 32, (bf16*)(ws + WS_WA0), 1024, 768 + (nb - 8), 2, nullptr, 0, WA_SCALE, scr, lane);
            continue; }
        r -= I_KVA;
        if (r < 2 * I_QB) { const int j = r / I_QB; r -= j * I_QB; const int kb = r / 48, nb = r % 48;
            const int n0 = nb * 32, head = n0 / 192, within = n0 - head * 192;
            const int drow = within < 128 ? n0 : head * 192 + 128 + ((within - 128) >> 5), dmul = within < 128 ? 1 : 2;
            tr_item(a.in[10] + (size_t)j * 384 * 1536, 1536, kb * 64, n0, (bf16*)(ws + WS_WQB + j * WQB_STRIDE), 384, drow, dmul, a.in[9] + j * 384, 511, 1.0f, scr, lane); continue; }
        r -= 2 * I_QB;
        if (r < I_KVB) { const int kb = r / 64, nb = r % 64;
            tr_item<true>(a.in[7], 2048, kb * 64, nb * 32, (bf16*)(ws + WS_WKVB), 256, nb * 32, 1, a.in[6], 255, WKVB_SCALE, scr, lane); continue; }
        r -= I_KVB;
        { const int j = r / I_WO; r -= j * I_WO; const int kb = r / 32, nb = r % 32;
          tr_item<true>(a.in[11] + (size_t)j * 1024 * 1024, 1024, kb * 64, nb * 32, (bf16*)(ws + WS_WMO + (size_t)j * 1024 * 1024), 1024, nb * 32, 1, nullptr, 0, WMO_SCALE, scr, lane); }
    }
    bf16* x16 = (bf16*)(ws + WS_X16);
#pragma unroll 1
    for (int m = gw * (T / NGW); m < (gw + 1) * (T / NGW); m += 4) {
        f32x4 v[4][4];
#pragma unroll
        for (int q = 0; q < 4; ++q) { const f32x4* xr = (const f32x4*)(a.in[0] + (size_t)(m + q) * D) + lane;
#pragma unroll
            for (int j = 0; j < 4; ++j) v[q][j] = xr[64 * j]; }
#pragma unroll
        for (int q = 0; q < 4; ++q) { u32x2* o8 = (u32x2*)(x16 + (size_t)(m + q) * D) + lane;
#pragma unroll
            for (int j = 0; j < 4; ++j) { u32x2 w; w.x = cvtpk(v[q][j][0], v[q][j][1]); w.y = cvtpk(v[q][j][2], v[q][j][3]); o8[64 * j] = w; } } }
    { bf16* wh = (bf16*)(ws + WS_RTW); bf16* wl = wh + 32 * 1024;
      for (int idx = gw * 64 + lane; idx < 32768; idx += NGW * 64) { const int k = idx >> 5, e = idx & 31; const float w = a.in[12][idx];
          const unsigned h = cvtpk(w, 0.f) & 0xffffu; const float r = w - __uint_as_float(h << 16); wh[e * 1024 + k] = (bf16)h; wl[e * 1024 + k] = (bf16)(cvtpk(r, 0.f) & 0xffffu); } }
    float* cosT = (float*)(ws + WS_COS); float* sinT = (float*)(ws + WS_SIN);
    for (int idx = gw * 64 + lane; idx < SEQ * 32; idx += NGW * 64) { const int pos = idx >> 5, i = idx & 31; const float ang = (float)pos * INV_FREQ[i]; float c, s; sincos_f64(ang, c, s); cosT[idx] = c; sinT[idx] = s; }
}
struct TrSrc { const float* p; int ldw; };
__device__ __forceinline__ void moe_item(const float* wg, const float* wu, const float* wd, int it, int part, TrSrc& s, unsigned char*& dst, int& ldt, unsigned char* gu, unsigned char* dn) {
    int e, r; if (part == 0) { e = it >> 8; r = it & 255; } else if (part == 1) { e = it >> 7; r = 256 + (it & 127); } else { e = it / 384; r = it - e * 384; }
    if (r < 256) { const int up = r >> 7; r &= 127; const int kb = r >> 3, nb = r & 7;
        s.p = (up ? wu : wg) + (size_t)e * 1024 * 256 + (size_t)(kb * 64) * 256 + nb * 32; s.ldw = 256;
        dst = gu + ((size_t)(e * 512 + (nb >> 2) * 256 + up * 128 + (nb & 3) * 32) * 1024 + kb * 64) * MOE_ES; ldt = 1024; }
    else { r -= 256; const int kb = r >> 5, nb = r & 31;
        s.p = wd + (size_t)e * 256 * 1024 + (size_t)(kb * 64) * 1024 + nb * 32; s.ldw = 1024;
        dst = dn + ((size_t)(e * 1024 + nb * 32) * 256 + kb * 64) * MOE_ES; ldt = 256; }
}
__device__ __forceinline__ void phase_moe_weights(const Args& a, int layer, int part, LAS unsigned char* lds, int gw, int NGW, int wave, int lane, int it_lo = 0, int it_hi = 1 << 30) {
    LAS float* scr = (LAS float*)(lds + wave * 8448);
    unsigned char* gu = a.ws + ((layer & 1) ? WS_MOEW2 : WS_MOEGU); unsigned char* dn = a.ws + ((layer & 1) ? WS_MOEW2 + 32 * MiB : WS_MOED);
    const float* wg = a.in[14] + (size_t)layer * NE * 1024 * 256; const float* wu = a.in[15] + (size_t)layer * NE * 1024 * 256; const float* wd = a.in[16] + (size_t)layer * NE * 256 * 1024;
    const int kr = lane >> 3, nc = (lane & 7) * 4;
    constexpr int NPF = 3;
    f32x4 buf[NPF][8]; unsigned char* bdst[NPF]; int bldt[NPF];
    const int nall = (part == 0) ? NE * 256 : (part == 1) ? NE * 128 : NE * 384, nitems = it_hi < nall ? it_hi : nall;
    const int it0 = it_lo + gw;
#pragma unroll
    for (int q = 0; q < NPF; ++q) { bdst[q] = nullptr; bldt[q] = 0; const int iq = it0 + q * NGW;
        if (iq < nitems) { TrSrc s; moe_item(wg, wu, wd, iq, part, s, bdst[q], bldt[q], gu, dn);
#pragma unroll
            for (int i = 0; i < 8; ++i) buf[q][i] = *(const f32x4*)(s.p + (size_t)(kr + 8 * i) * s.ldw + nc); } }
#pragma unroll 1
    for (int it = it0; it < nitems; it += NPF * NGW) {
#pragma unroll
        for (int q = 0; q < NPF; ++q) { const int cur = it + q * NGW;
            if (cur < nitems) {
                f32x4 v[8];
#pragma unroll
                for (int i = 0; i < 8; ++i) v[i] = buf[q][i];
                unsigned char* cdst = bdst[q]; const int cldt = bldt[q];
                if (cur + NPF * NGW < nitems) { TrSrc s; moe_item(wg, wu, wd, cur + NPF * NGW, part, s, bdst[q], bldt[q], gu, dn);
#pragma unroll
                    for (int i = 0; i < 8; ++i) buf[q][i] = *(const f32x4*)(s.p + (size_t)(kr + 8 * i) * s.ldw + nc); }
#pragma unroll
                for (int i = 0; i < 8; ++i) { LAS float* w = scr + (kr + 8 * i) * 33 + nc; const f32x4 t = MOE_F8 ? v[i] * MOEW_SCALE : v[i]; w[0] = t[0]; w[1] = t[1]; w[2] = t[2]; w[3] = t[3]; }
                LDS_WAIT(); asm volatile("" ::: "memory");
                const int c = lane & 7;
#pragma unroll
                for (int j = 0; j < 4; ++j) { const int n = (lane >> 3) + 8 * j; const LAS float* sp = scr + (8 * c) * 33 + n;
                    if constexpr (MOE_F8) { const f32x4 x0 = {sp[0 * 33], sp[1 * 33], sp[2 * 33], sp[3 * 33]}, x1 = {sp[4 * 33], sp[5 * 33], sp[6 * 33], sp[7 * 33]};
                        *(u32x2*)(cdst + (size_t)n * cldt + 8 * c) = pack8_f8(x0, x1); }
                    else { u32x4 o; o.x = cvtpk(sp[0 * 33], sp[1 * 33]); o.y = cvtpk(sp[2 * 33], sp[3 * 33]); o.z = cvtpk(sp[4 * 33], sp[5 * 33]); o.w = cvtpk(sp[6 * 33], sp[7 * 33]);
                        *(u32x4*)(cdst + ((size_t)n * cldt + 8 * c) * 2) = o; } }
                LDS_WAIT(); asm volatile("" ::: "memory");
            } }
    }
}
__device__ __forceinline__ void phase_combine(const bf16* oc, bf16* o, const float* lam, float lambda_init, int gw, int NGW, int lane) {
    const float s1 = wave_sum(lam[lane] * lam[64 + lane], lane), s2 = wave_sum(lam[128 + lane] * lam[192 + lane], lane);
    const float lamf = expf(s1) - expf(s2) + lambda_init;
    for (int row = gw; row < T; row += NGW) {
#pragma unroll
        for (int i = 0; i < 2; ++i) { const int c = lane + 64 * i, head = c >> 4, off = (c & 15) * 8;
            const u32x4 a = *(const u32x4*)(oc + (size_t)row * 2048 + (2 * head) * 128 + off), b = *(const u32x4*)(oc + (size_t)row * 2048 + (2 * head + 1) * 128 + off);
            float d[8];
#pragma unroll
            for (int k = 0; k < 4; ++k) { d[2 * k] = bf_lo(a[k]) - lamf * bf_lo(b[k]); d[2 * k + 1] = bf_hi(a[k]) - lamf * bf_hi(b[k]); }
            float ss = 0.f;
#pragma unroll
            for (int k = 0; k < 8; ++k) ss += d[k] * d[k];
            ss += shx(ss, 1, lane); ss += shx(ss, 2, lane); ss += shx(ss, 4, lane); ss += shx(ss, 8, lane);
            const float r = 1.0f / sqrtf(ss * (1.0f / 128.0f) + LN_EPS);
            u32x4 w; w.x = cvtpk(d[0] * r, d[1] * r); w.y = cvtpk(d[2] * r, d[3] * r); w.z = cvtpk(d[4] * r, d[5] * r); w.w = cvtpk(d[6] * r, d[7] * r);
            *(u32x4*)(o + (size_t)row * D + head * 128 + off) = w; }
    }
}
__device__ __forceinline__ void top2_of4(float a0, float a1, float a2, float a3, int& i0, int& i1, float& v0, float& v1) {
    i0 = 0; v0 = a0; if (a1 > v0) { v0 = a1; i0 = 1; } if (a2 > v0) { v0 = a2; i0 = 2; } if (a3 > v0) { v0 = a3; i0 = 3; }
    v1 = -3.0e38f; i1 = 0;
    if (i0 != 0 && a0 > v1) { v1 = a0; i1 = 0; } if (i0 != 1 && a1 > v1) { v1 = a1; i1 = 1; } if (i0 != 2 && a2 > v1) { v1 = a2; i1 = 2; } if (i0 != 3 && a3 > v1) { v1 = a3; i1 = 3; }
}
__device__ __forceinline__ void route_rows8(const LAS float* Lg, const float* router_b, int lrow_base, int lane, LAS int* cnt, LAS int* pe, LAS int* prank, LAS float* pgate) {
    const int q = lane >> 3, g = lane & 7, lrow = lrow_base + q;
    const f32x4 rb = *(const f32x4*)(router_b + 4 * g);
    float sc[4], sel[4];
#pragma unroll
    for (int i = 0; i < 4; ++i) { sc[i] = 1.0f / (1.0f + expf(-Lg[lrow * 33 + 4 * g + i])); sel[i] = sc[i] + rb[i]; }
    int i0, i1; float v0, v1; top2_of4(sel[0], sel[1], sel[2], sel[3], i0, i1, v0, v1);
    float gs = v0 + v1; int gi = g;
    { const float os = dppf<0xB1>(gs); const int oi = dppi<0xB1>(gi); if (os > gs || (os == gs && oi < gi)) { gs = os; gi = oi; } }
    { const float os = dppf<0x4E>(gs); const int oi = dppi<0x4E>(gi); if (os > gs || (os == gs && oi < gi)) { gs = os; gi = oi; } }
    { const float os = dppf<0x141>(gs); const int oi = dppi<0x141>(gi); if (os > gs || (os == gs && oi < gi)) { gs = os; gi = oi; } }
    if (g == gi) { const float g0 = i0 == 0 ? sc[0] : i0 == 1 ? sc[1] : i0 == 2 ? sc[2] : sc[3], g1 = i1 == 0 ? sc[0] : i1 == 1 ? sc[1] : i1 == 2 ? sc[2] : sc[3];
        const int e0 = 4 * g + i0, e1 = 4 * g + i1; const float inv = 1.0f / (g0 + g1);
        const int r0 = __hip_atomic_fetch_add(cnt + e0, 1, __ATOMIC_RELAXED, __HIP_MEMORY_SCOPE_WORKGROUP), r1 = __hip_atomic_fetch_add(cnt + e1, 1, __ATOMIC_RELAXED, __HIP_MEMORY_SCOPE_WORKGROUP);
        pe[2 * lrow] = e0; pe[2 * lrow + 1] = e1; prank[2 * lrow] = r0; prank[2 * lrow + 1] = r1; pgate[2 * lrow] = g0 * inv; pgate[2 * lrow + 1] = g1 * inv; }
}
__device__ __forceinline__ void phase_ln_router(const bf16* xin, bf16* x16, unsigned char* x8, float* stat, const float* g, const float* b, const bf16* wr_hi, const bf16* wr_lo, const float* router_b,
                                                int* tk_e, int* tk_pos, float* tk_gate, unsigned* gcount, int* list, LAS unsigned char* lds, int tid, int wave, int lane, int bid) {
    LAS int* cnt = (LAS int*)(lds + MISC_OFF + MO_CNT); LAS int* wbase = (LAS int*)(lds + MISC_OFF + MO_WBASE);
    LAS int* pe = (LAS int*)(lds + MISC_OFF + MO_PE); LAS int* prank = (LAS int*)(lds + MISC_OFF + MO_PRANK); LAS float* pgate = (LAS float*)(lds + MISC_OFF + MO_PGATE);
    const int lrow_base = wave * (RPW / NWAVES), row_base = bid * RPW + lrow_base;
    if (tid < 32) cnt[tid] = 0;
    bf16x8 rwh[2][4], rwl[2][4];
    { const int fr_ = lane & 15, kg_ = lane >> 4;
#pragma unroll
      for (int nt = 0; nt < 2; ++nt)
#pragma unroll
        for (int ks = 0; ks < 4; ++ks) { const size_t o_ = (size_t)(16 * nt + fr_) * D + 8 * kg_ + 32 * (4 * wave + ks); rwh[nt][ks] = *(const bf16x8*)(wr_hi + o_); rwl[nt][ks] = *(const bf16x8*)(wr_lo + o_); } }
    f32x4 gl[2][2], bl[2][2];
#pragma unroll
    for (int j = 0; j < 2; ++j)
#pragma unroll
        for (int h = 0; h < 2; ++h) { gl[j][h] = *((const f32x4*)g + 2 * (lane + 64 * j) + h); bl[j][h] = *((const f32x4*)b + 2 * (lane + 64 * j) + h); }
#pragma unroll 1
    for (int it = 0; it < RPW / NWAVES / 4; ++it) {
        u32x4 xw[4][2];
#pragma unroll
        for (int q = 0; q < 4; ++q)
#pragma unroll
            for (int j = 0; j < 2; ++j) xw[q][j] = *((const u32x4*)(xin + (size_t)(row_base + 4 * it + q) * D) + lane + 64 * j);
#pragma unroll
        for (int q = 0; q < 4; ++q) { const int lr = lrow_base + 4 * it + q;
            f32x4 v[2][2]; float s = 0.f;
#pragma unroll
            for (int j = 0; j < 2; ++j)
#pragma unroll
                for (int h = 0; h < 2; ++h) { const unsigned w0 = xw[q][j][2 * h], w1 = xw[q][j][2 * h + 1]; v[j][h][0] = bf_lo(w0); v[j][h][1] = bf_hi(w0); v[j][h][2] = bf_lo(w1); v[j][h][3] = bf_hi(w1);
                    s += (v[j][h][0] + v[j][h][1]) + (v[j][h][2] + v[j][h][3]); }
            const float mean = wave_sum(s, lane) * (1.f / D); float s2 = 0.f;
#pragma unroll
            for (int j = 0; j < 2; ++j)
#pragma unroll
                for (int h = 0; h < 2; ++h) { v[j][h] = v[j][h] - mean; s2 += (v[j][h][0] * v[j][h][0] + v[j][h][1] * v[j][h][1]) + (v[j][h][2] * v[j][h][2] + v[j][h][3] * v[j][h][3]); }
            const float rstd = 1.f / sqrtf(wave_sum(s2, lane) * (1.f / D) + LN_EPS);
            u32x4* o16 = (u32x4*)(x16 + (size_t)(bid * RPW + lr) * D) + lane;
            if (MOE_F8 && lane == 0) { stat[2 * (bid * RPW + lr)] = mean; stat[2 * (bid * RPW + lr) + 1] = rstd; }
#pragma unroll
            for (int j = 0; j < 2; ++j) { const f32x4 n0 = v[j][0] * rstd * gl[j][0] + bl[j][0], n1 = v[j][1] * rstd * gl[j][1] + bl[j][1]; const u32x4 w = pack8(n0, n1); if constexpr (!MOE_F8) o16[64 * j] = w;
                if constexpr (MOE_F8) *((u32x2*)(x8 + (size_t)(bid * RPW + lr) * D) + lane + 64 * j) = pack8_f8(n0, n1);
                const int c = lane + 64 * j;
                *(LAS u32x4*)(lds + lr * 2048 + ((c ^ (lr & 15)) << 4)) = w; }
        }
    }
    __syncthreads();
    {
        typedef float f32x4v __attribute__((ext_vector_type(4)));
        const int fr = lane & 15, kg = lane >> 4;
        f32x4v acc[4][2];
#pragma unroll
        for (int mt = 0; mt < 4; ++mt)
#pragma unroll
            for (int nt = 0; nt < 2; ++nt) acc[mt][nt] = (f32x4v){0.f, 0.f, 0.f, 0.f};
#pragma unroll
        for (int ks = 0; ks < 4; ++ks)
#pragma unroll
            for (int mt = 0; mt < 4; ++mt) { const int lr = 16 * mt + fr, c = 4 * (4 * wave + ks) + kg;
                const bf16x8 a = *(const LAS bf16x8*)(lds + lr * 2048 + ((c ^ (lr & 15)) << 4));
#pragma unroll
                for (int nt = 0; nt < 2; ++nt) { acc[mt][nt] = __builtin_amdgcn_mfma_f32_16x16x32_bf16(a, rwh[nt][ks], acc[mt][nt], 0, 0, 0); acc[mt][nt] = __builtin_amdgcn_mfma_f32_16x16x32_bf16(a, rwl[nt][ks], acc[mt][nt], 0, 0, 0); } }
        __syncthreads();
        LAS float* Pp = (LAS float*)lds + wave * (64 * 33);
#pragma unroll
        for (int mt = 0; mt < 4; ++mt)
#pragma unroll
            for (int nt = 0; nt < 2; ++nt)
#pragma unroll
                for (int j = 0; j < 4; ++j) Pp[(16 * mt + 4 * kg + j) * 33 + 16 * nt + fr] = acc[mt][nt][j];
        __syncthreads();
        LAS float* Lg = (LAS float*)(lds + 8 * 64 * 33 * 4);
        for (int e = tid; e < 64 * 33; e += NTHREADS) { float t = 0.f;
#pragma unroll
            for (int w = 0; w < 8; ++w) t += ((const LAS float*)lds)[w * (64 * 33) + e];
            Lg[e] = t; }
    }
    __syncthreads();
    static_assert(RPW / NWAVES == 8, "route_rows8 handles a wave's eight rows");
    route_rows8((const LAS float*)(lds + 8 * 64 * 33 * 4), router_b, lrow_base, lane, cnt, pe, prank, pgate);
    __syncthreads();
    if (tid < 32) { const int c = cnt[tid]; wbase[tid] = c ? (int)__hip_atomic_fetch_add(gcount + tid, (unsigned)c, __ATOMIC_RELAXED, __HIP_MEMORY_SCOPE_AGENT) : 0; }
    __syncthreads();
    if (tid < 2 * RPW) { const int e = pe[tid], pos = wbase[e] + prank[tid], idx = bid * RPW * 2 + tid;
        tk_e[idx] = e; tk_pos[idx] = pos; tk_gate[idx] = pgate[tid]; list[e * T + pos] = idx >> 1; }
}
__device__ __forceinline__ void phase_ln_moe(const bf16* x16, const float* stat, const float* lng1, const float* lnb1, bf16* x16o, unsigned char* x8, float* xout,
                                              const bf16* y, const int* tk_e, const int* tk_pos, const float* tk_gate, const LAS int* pbase, const float* g, const float* b, int gw, int NGW, int lane) {
    f32x4 gl[2][2], bl[2][2];
#pragma unroll
    for (int j = 0; j < 2; ++j)
#pragma unroll
        for (int h = 0; h < 2; ++h) { gl[j][h] = *((const f32x4*)g + 2 * (lane + 64 * j) + h); bl[j][h] = *((const f32x4*)b + 2 * (lane + 64 * j) + h); }
    f32x4 ga[2][2], ba[2][2];
    if constexpr (MOE_F8) {
#pragma unroll
        for (int j = 0; j < 2; ++j)
#pragma unroll
            for (int h = 0; h < 2; ++h) { ga[j][h] = *((const f32x4*)lng1 + 2 * (lane + 64 * j) + h) * ALPHA; ba[j][h] = *((const f32x4*)lnb1 + 2 * (lane + 64 * j) + h) * ALPHA; } }
#pragma unroll 1
    for (int row0 = gw * (T / NGW); row0 < (gw + 1) * (T / NGW); row0 += 4) {
        int s0[4], s1[4]; float g0[4], g1[4]; float mu[4], rs[4];
        if constexpr (MOE_F8) {
#pragma unroll
            for (int q = 0; q < 4; ++q) { const int row = row0 + q; mu[q] = stat[2 * row]; rs[q] = stat[2 * row + 1]; } }
#pragma unroll
        for (int q = 0; q < 4; ++q) { const int row = row0 + q; s0[q] = pbase[tk_e[2 * row]] * 256 + tk_pos[2 * row]; s1[q] = pbase[tk_e[2 * row + 1]] * 256 + tk_pos[2 * row + 1]; g0[q] = tk_gate[2 * row]; g1[q] = tk_gate[2 * row + 1]; }
        u32x4 xa[4][2], ya[4][2], yc[4][2]; u32x2 ya8[4][2], yc8[4][2];
#pragma unroll
        for (int q = 0; q < 4; ++q) { const int row = row0 + q;
            const u32x4* xr = (const u32x4*)(x16 + (size_t)row * D) + lane; const u32x4* y0 = (const u32x4*)(y + (size_t)s0[q] * D) + lane; const u32x4* y1 = (const u32x4*)(y + (size_t)s1[q] * D) + lane;
            const u32x2* z0 = (const u32x2*)((const unsigned char*)y + (size_t)s0[q] * D) + lane; const u32x2* z1 = (const u32x2*)((const unsigned char*)y + (size_t)s1[q] * D) + lane;
#pragma unroll
            for (int j = 0; j < 2; ++j) { xa[q][j] = xr[64 * j]; if constexpr (Y_F8) { ya8[q][j] = z0[64 * j]; yc8[q][j] = z1[64 * j]; } else { ya[q][j] = y0[64 * j]; yc[q][j] = y1[64 * j]; } } }
#pragma unroll
        for (int q = 0; q < 4; ++q) { const int row = row0 + q;
            f32x4 v[2][2]; float s = 0.f;
#pragma unroll
            for (int j = 0; j < 2; ++j)
#pragma unroll
                for (int h = 0; h < 2; ++h) { const unsigned xw0 = xa[q][j][2 * h], xw1 = xa[q][j][2 * h + 1];
                    if constexpr (Y_F8) { const f32x2 a0 = __builtin_amdgcn_cvt_pk_f32_fp8((int)ya8[q][j][h], false), a1 = __builtin_amdgcn_cvt_pk_f32_fp8((int)ya8[q][j][h], true);
                        const f32x2 c0 = __builtin_amdgcn_cvt_pk_f32_fp8((int)yc8[q][j][h], false), c1 = __builtin_amdgcn_cvt_pk_f32_fp8((int)yc8[q][j][h], true);
                        const float e0 = g0[q] * (1.0f / Y_SCALE), e1 = g1[q] * (1.0f / Y_SCALE);
                        f32x4 xr4 = {bf_lo(xw0), bf_hi(xw0), bf_lo(xw1), bf_hi(xw1)};
                        if constexpr (MOE_F8) xr4 = (xr4 - mu[q]) * rs[q] * ga[j][h] + ba[j][h]; else xr4 = xr4 * ALPHA;
                        v[j][h][0] = xr4[0] + (e0 * a0[0] + e1 * c0[0]); v[j][h][1] = xr4[1] + (e0 * a0[1] + e1 * c0[1]);
                        v[j][h][2] = xr4[2] + (e0 * a1[0] + e1 * c1[0]); v[j][h][3] = xr4[3] + (e0 * a1[1] + e1 * c1[1]); }
                    else { const unsigned aw0 = ya[q][j][2 * h], aw1 = ya[q][j][2 * h + 1], cw0 = yc[q][j][2 * h], cw1 = yc[q][j][2 * h + 1];
                    v[j][h][0] = bf_lo(xw0) * ALPHA + (g0[q] * bf_lo(aw0) + g1[q] * bf_lo(cw0)); v[j][h][1] = bf_hi(xw0) * ALPHA + (g0[q] * bf_hi(aw0) + g1[q] * bf_hi(cw0));
                    v[j][h][2] = bf_lo(xw1) * ALPHA + (g0[q] * bf_lo(aw1) + g1[q] * bf_lo(cw1)); v[j][h][3] = bf_hi(xw1) * ALPHA + (g0[q] * bf_hi(aw1) + g1[q] * bf_hi(cw1)); }
                    s += (v[j][h][0] + v[j][h][1]) + (v[j][h][2] + v[j][h][3]); }
            const float mean = wave_sum(s, lane) * (1.f / D); float s2 = 0.f;
#pragma unroll
            for (int j = 0; j < 2; ++j)
#pragma unroll
                for (int h = 0; h < 2; ++h) { v[j][h] = v[j][h] - mean; s2 += (v[j][h][0] * v[j][h][0] + v[j][h][1] * v[j][h][1]) + (v[j][h][2] * v[j][h][2] + v[j][h][3] * v[j][h][3]); }
            const float rstd = 1.f / sqrtf(wave_sum(s2, lane) * (1.f / D) + LN_EPS);
            if (xout) { f32x4* xw = (f32x4*)(xout + (size_t)row * D);
#pragma unroll
                for (int j = 0; j < 2; ++j)
#pragma unroll
                    for (int h = 0; h < 2; ++h) xw[2 * (lane + 64 * j) + h] = v[j][h] * rstd * gl[j][h] + bl[j][h]; }
            else { u32x4* o16 = (u32x4*)(x16o + (size_t)row * D) + lane; u32x2* o8 = (u32x2*)(x8 + (size_t)row * D) + lane;
#pragma unroll
                for (int j = 0; j < 2; ++j) { const f32x4 n0 = v[j][0] * rstd * gl[j][0] + bl[j][0], n1 = v[j][1] * rstd * gl[j][1] + bl[j][1]; o16[64 * j] = pack8(n0, n1); if (x8) o8[64 * j] = pack8_f8(n0, n1); } }
        }
    }
}

#define CAS __attribute__((address_space(4)))
extern __shared__ __attribute__((aligned(16))) unsigned char lds_raw[];
__device__ __forceinline__ const CAS Args* kargs() { return (const CAS Args*)__builtin_amdgcn_kernarg_segment_ptr(); }
#define PH_COMMON const CAS Args* ka = kargs(); asm volatile("" : "+s"(ka)); unsigned char* ws = ka->ws; LAS unsigned char* lds = (LAS unsigned char*)lds_raw; \
    const int tid = mk_tid(wv); const int lane = tid & 63, wave = wv; int G = gridDim.x, bid = blockIdx.x; asm volatile("" : "+s"(G), "+s"(bid)); const int gw = bid * NWAVES + wave, NGW = G * NWAVES; \
    (void)ws; (void)lds; (void)lane; (void)wave; (void)gw; (void)NGW; (void)G; (void)bid;
#define PH_FN static __device__ __forceinline__ void

__device__ __forceinline__ Args load_args(const CAS Args* ka) { Args a; for (int i = 0; i < 19; ++i) a.in[i] = ka->in[i]; a.out = ka->out; a.ws = ka->ws; a.ph_lo = ka->ph_lo; a.ph_hi = ka->ph_hi; return a; }

PH_FN ph_prologue(int wv) { PH_COMMON const Args a = load_args(ka); phase_prologue(a, lds, gw, NGW, wave, lane); phase_moe_weights(a, 0, 2, lds, gw, NGW, wave, lane); }
PH_FN ph_moe_weights(int wv, int L_) { PH_COMMON const int L = __builtin_amdgcn_readfirstlane(L_); const Args a = load_args(ka); phase_moe_weights(a, L, 2, lds, gw, NGW, wave, lane); }
PH_FN ph_qkv(int wv, int L_) { PH_COMMON const int L = __builtin_amdgcn_readfirstlane(L_);
    pg8::Gemm g{(const bf16*)(ws + WS_X16), (const bf16*)(ws + WS_WQKV) + (size_t)L * 3072 * 1024, T, 3072, 1024}; pg8::StaticOrder S; S.init(T, 3072, G, bid);
    EpiStore E{(bf16*)(ws + WS_RA + RA_QKV), 3072};
    pg8::gemm_phase<EpiStore, pg8::StaticOrder, true, true>(lds, g, S, E, wv); }
PH_FN ph_attn_diff(int wv, int L_) { PH_COMMON const int L = __builtin_amdgcn_readfirstlane(L_);
    const bf16* qkv = (const bf16*)(ws + WS_RA + RA_QKV); bf16* od = (bf16*)(ws + WS_RB + RB_OD);
    const float* lamp = ka->in[2] + L * 256;
    const float s1 = wave_sum(lamp[lane] * lamp[64 + lane], lane), s2 = wave_sum(lamp[128 + lane] * lamp[192 + lane], lane);
    const float lam = expf(s1) - expf(s2) + lambda_init_of(L);
    for (int p = bid; p < 256; p += G) {
        const int gid = (p & 7) * 2 + ((p >> 3) >> 4), k = (p >> 3) & 15;
#pragma unroll 1
        for (int t = 0; t < 2; ++t) { const int qb = t ? 15 - k : k, b = gid >> 2, h = t ? (gid & 3) : 7 - (gid & 3);
            const float slope2 = exp2f(-(float)(h + 1)) * LOG2E;
            const bf16* kb = qkv + (size_t)b * SEQ * 3072;
#pragma unroll 1
            for (int cc = 0; cc < 2; ++cc)
                att::unit3<64, true>(kb + (size_t)qb * 256 * 3072 + h * 128 + cc * 64, 3072, kb + 1024 + h * 128 + cc * 64, 3072, nullptr, 0, kb + 2048 + h * 128, 3072,
                                     od + ((size_t)b * SEQ + qb * 256) * 1024 + h * 128, 1024, qb, t != 0, slope2, 1 + cc, lam, lds, wv); }
    } }
PH_FN ph_mla_a(int wv, int j_) { PH_COMMON const int j = __builtin_amdgcn_readfirstlane(j_);
    const int N = j ? 512 : 1024;
    pg8::Gemm g{(const bf16*)(ws + WS_X8), (const bf16*)(ws + (j ? WS_WA1 : WS_WA0)), T, N, 512}; pg8::StaticOrder S; S.init(T, N, G, bid);
    EpiMlaA E{(bf16*)(ws + WS_RA + RA_QA), (unsigned char*)(ws + WS_RA + RA_CKV), (bf16*)(ws + WS_RB + RB_KROPE), (float*)(ws + WS_SSQQ), (float*)(ws + WS_SSQKV), (const float*)(ws + WS_COS), (const float*)(ws + WS_SIN), 1.0f / WA_SCALE};
    pg8::gemm_phase<EpiMlaA, pg8::StaticOrder, true, true, true>(lds, g, S, E, wv); }
PH_FN ph_mla_qb(int wv, int j_) { PH_COMMON const int j = __builtin_amdgcn_readfirstlane(j_);
    pg8::Gemm g{(const bf16*)(ws + WS_RA + RA_QA), (const bf16*)(ws + WS_WQB + j * WQB_STRIDE), T, 1536, 384}; pg8::StaticOrder S; S.init(T, 1536, G, bid);
    EpiQB E{(bf16*)(ws + WS_RA + RA_Q), (const float*)(ws + WS_SSQQ), (const float*)(ws + WS_COS), (const float*)(ws + WS_SIN), 0.07216878364870322f * LOG2E / K8_SCALE};
    pg8::gemm_phase<EpiQB, pg8::StaticOrder, true, true>(lds, g, S, E, wv); }
PH_FN ph_mla_kvb(int wv) { PH_COMMON
    pg8::Gemm g{(const bf16*)(ws + WS_RA + RA_CKV), (const bf16*)(ws + WS_WKVB), T, 2048, 128}; pg8::StaticOrder S; S.init(T, 2048, G, bid);
    EpiKVB E{(bf16*)(ws + WS_RB + RB_KV), (unsigned char*)(ws + WS_K8), (const float*)(ws + WS_SSQKV), 1.0f / WKVB_SCALE};
    pg8::gemm_phase<EpiKVB, pg8::StaticOrder, true, true, true>(lds, g, S, E, wv); }
PH_FN ph_attn_mla(int wv) { PH_COMMON
    const bf16* q = (const bf16*)(ws + WS_RA + RA_Q); bf16* om = (bf16*)(ws + WS_RA + RA_O_MLA); const bf16* kv = (const bf16*)(ws + WS_RB + RB_KV); const bf16* krope = (const bf16*)(ws + WS_RB + RB_KROPE);
    for (int p = bid; p < 256; p += G) {
        const int gid = (p & 7) * 2 + ((p >> 3) >> 4), k = (p >> 3) & 15;
#pragma unroll 1
        for (int t = 0; t < 2; ++t) { const int combo = gid * 2 + t, qb = t ? 15 - k : k, b = combo >> 3, h = combo & 7;
            att::unit3<192, false, true, true>((const bf16*)((const unsigned char*)q + ((size_t)b * SEQ + qb * 256) * 1536 + h * 192), 1536, (const bf16*)(ws + WS_K8 + (size_t)b * SEQ * 1024 + h * 128), 1024, (const bf16*)((const unsigned char*)krope + (size_t)b * SEQ * 64), 64,
                                  kv + (size_t)b * SEQ * 2048 + h * 256 + 128, 2048, (bf16*)((unsigned char*)om + ((size_t)b * SEQ + qb * 256) * 1024 + h * 128), 1024, qb, t != 0, 0.f, 0, 0.f, lds, wv); }
    } }
PH_FN ph_wo(int wv, int L_, bool dummy) { PH_COMMON const int L = __builtin_amdgcn_readfirstlane(L_);
    pg8::StaticOrder S; S.init(T, 1024, G, bid);
    if (L < 2) { pg8::Gemm g{(const bf16*)(ws + WS_RB + RB_OD), (const bf16*)(ws + WS_WO) + (size_t)L * 1024 * 1024, T, 1024, 1024};
        EpiRes E{L == 0 ? ka->in[0] : (const float*)nullptr, (const bf16*)(ws + WS_X16), (bf16*)(ws + WS_XPRE), 1.0f};
        pg8::gemm_phase<EpiRes, pg8::StaticOrder, true, true>(lds, g, S, E, wv); }
    else {
        pg8::Gemm g{(const bf16*)(ws + WS_RA + RA_O_MLA), (const bf16*)(ws + WS_WMO + (size_t)(L - 2) * 1024 * 1024), T, 1024, 512};
        EpiRes E{(const float*)nullptr, (const bf16*)(ws + WS_X16), (bf16*)(ws + WS_XPRE), 1.0f / (att::O8_SCALE * WMO_SCALE)};
        pg8::gemm_phase<EpiRes, pg8::StaticOrder, true, true, true>(lds, g, S, E, wv); } }
PH_FN ph_ln_router(int wv, int L_) { PH_COMMON const int L = __builtin_amdgcn_readfirstlane(L_);
    if (PROBE_DUP == 7) { phase_ln_router((const bf16*)(ws + WS_XPRE), (bf16*)(ws + WS_RA), (unsigned char*)(ws + WS_RA + 32 * MiB), (float*)(ws + WS_RA + 52 * MiB), ka->in[17] + (size_t)(L * 2) * D, ka->in[18] + (size_t)(L * 2) * D, (const bf16*)(ws + WS_RTW), (const bf16*)(ws + WS_RTW) + 32 * 1024, ka->in[13],
                    (int*)(ws + WS_RA + 48 * MiB), (int*)(ws + WS_RA + 49 * MiB), (float*)(ws + WS_RA + 50 * MiB), (unsigned*)(ws + WS_CTL) + CW_GCOUNT + (4 + L) * 64, (int*)(ws + WS_Y), lds, tid, wave, lane, bid); __syncthreads(); }
    phase_ln_router((const bf16*)(ws + WS_XPRE), (bf16*)(ws + WS_X16), (unsigned char*)(ws + WS_X8), (float*)(ws + WS_STAT), ka->in[17] + (size_t)(L * 2) * D, ka->in[18] + (size_t)(L * 2) * D, (const bf16*)(ws + WS_RTW), (const bf16*)(ws + WS_RTW) + 32 * 1024, ka->in[13],
                    (int*)(ws + WS_TKE), (int*)(ws + WS_TKPOS), (float*)(ws + WS_TKGATE), (unsigned*)(ws + WS_CTL) + CW_GCOUNT + L * 64, (int*)(ws + WS_LIST), lds, tid, wave, lane, bid); }
PH_FN ph_up(int wv, int L_) { PH_COMMON const int L = __builtin_amdgcn_readfirstlane(L_);
    LAS int* pbase = (LAS int*)(lds + MISC_OFF + MO_PBASE); LAS int* ne = (LAS int*)(lds + MISC_OFF + MO_NE);
    LAS int* utab = (LAS int*)(lds + MISC_OFF + MO_UTAB);
    moe_table((const unsigned*)(ws + WS_CTL) + CW_GCOUNT + L * 64, pbase, ne, wave, lane); __syncthreads();
    const int xq = bid & 7, yq = bid >> 3, YN = G >> 3, nunits = pbase[32] * 2;
    int gwx = YN; if (L < 3) { gwx = (nunits + 15) >> 4; gwx = gwx < YN / 2 ? YN / 2 : gwx; gwx = gwx > YN ? YN : gwx; }
    moe_units<2>(pbase, utab, 8 * gwx, xq * gwx + (yq < gwx ? yq : 0), wave, lane); __syncthreads();
    if (yq < gwx) {
        pg8::Gemm g{(const bf16*)(ws + (MOE_F8 ? WS_X8 : WS_X16)), (const bf16*)(ws + ((L & 1) ? WS_MOEW2 : WS_MOEGU)), T, NE * 512, 512 * MOE_ES}; MoeOrd<2, true> S; S.init(pbase, ne, utab, (const int*)(ws + WS_LIST));
        EpiUp E{(bf16*)(ws + WS_RA + RA_H), MOE_F8 ? 1.0f / MOEW_SCALE : 1.0f};
        pg8::gemm_phase<EpiUp, MoeOrd<2, true>, true, true, MOE_F8>(lds, g, S, E, wv);
        if (L < 3 && gwx == YN) { __syncthreads(); const Args a = load_args(ka); const int vcu = xq * YN + yq; phase_moe_weights(a, L + 1, 2, lds, vcu * NWAVES + wv, G * NWAVES, wv, mk_lane()); }
    } else { const Args a = load_args(ka); phase_moe_weights(a, L + 1, 2, lds, (xq * (YN - gwx) + (yq - gwx)) * NWAVES + wv, 8 * (YN - gwx) * NWAVES, wv, mk_lane()); }
}
PH_FN ph_down(int wv, int L_) { PH_COMMON const int L = __builtin_amdgcn_readfirstlane(L_);
    LAS int* pbase = (LAS int*)(lds + MISC_OFF + MO_PBASE); LAS int* ne = (LAS int*)(lds + MISC_OFF + MO_NE);
    LAS int* utab = (LAS int*)(lds + MISC_OFF + MO_UTAB);
    if (!MK_SINGLE) { moe_table((const unsigned*)(ws + WS_CTL) + CW_GCOUNT + L * 64, pbase, ne, wave, lane); __syncthreads(); }
    moe_units<4>(pbase, utab, G, (bid & 7) * (G >> 3) + (bid >> 3), wave, lane); __syncthreads();
    pg8::Gemm g{(const bf16*)(ws + WS_RA + RA_H), (const bf16*)(ws + ((L & 1) ? WS_MOEW2 + 32 * MiB : WS_MOED)), SLOT_CAP, NE * 1024, 128 * MOE_ES}; MoeOrd<4, false> S; S.init(pbase, ne, utab, nullptr);
    EpiDown E{(bf16*)(ws + WS_Y), (MOE_F8 ? 1.0f / (MOEW_SCALE * H_SCALE) : 1.0f) * (Y_F8 ? Y_SCALE : 1.0f)};
    pg8::gemm_phase<EpiDown, MoeOrd<4, false>, true, true, MOE_F8>(lds, g, S, E, wv);
}
PH_FN ph_ln_moe(int wv, int L_) { PH_COMMON const int L = __builtin_amdgcn_readfirstlane(L_);
    LAS int* pbase = (LAS int*)(lds + MISC_OFF + MO_PBASE); LAS int* ne = (LAS int*)(lds + MISC_OFF + MO_NE);
    if (!MK_SINGLE) { moe_table((const unsigned*)(ws + WS_CTL) + CW_GCOUNT + L * 64, pbase, ne, wave, lane); __syncthreads(); }
    if (PROBE_DUP == 8) { phase_ln_moe((const bf16*)(ws + (MOE_F8 ? WS_XPRE : WS_X16)), (const float*)(ws + WS_STAT), ka->in[17] + (size_t)(L * 2) * D, ka->in[18] + (size_t)(L * 2) * D, (bf16*)(ws + WS_RA), (unsigned char*)(ws + WS_RA + 32 * MiB), (float*)nullptr, (const bf16*)(ws + WS_Y), (const int*)(ws + WS_TKE), (const int*)(ws + WS_TKPOS), (const float*)(ws + WS_TKGATE), pbase,
                 ka->in[17] + (size_t)(L * 2 + 1) * D, ka->in[18] + (size_t)(L * 2 + 1) * D, gw, NGW, lane); __syncthreads(); }
    phase_ln_moe((const bf16*)(ws + (MOE_F8 ? WS_XPRE : WS_X16)), (const float*)(ws + WS_STAT), ka->in[17] + (size_t)(L * 2) * D, ka->in[18] + (size_t)(L * 2) * D, (bf16*)(ws + WS_X16), (L == 1 || L == 2) ? (unsigned char*)(ws + WS_X8) : (unsigned char*)nullptr, L == 3 ? ka->out : (float*)nullptr, (const bf16*)(ws + WS_Y), (const int*)(ws + WS_TKE), (const int*)(ws + WS_TKPOS), (const float*)(ws + WS_TKGATE), pbase,
                 ka->in[17] + (size_t)(L * 2 + 1) * D, ka->in[18] + (size_t)(L * 2 + 1) * D, gw, NGW, lane); }

constexpr int NPH = 31;
__global__ void __launch_bounds__(NTHREADS, 2) mk_fwd(Args a) {
    LAS unsigned char* lds = (LAS unsigned char*)lds_raw;
    const int wv = __builtin_amdgcn_readfirstlane((int)threadIdx.x >> 6); const int tid = mk_tid(wv);
    volatile LAS unsigned* MISC = (volatile LAS unsigned*)(lds + MISC_OFF);
    if (tid < 64) MISC[tid] = 0u;
    __syncthreads();
#if MK_SINGLE
    XcdBarrier bar = xcd_barrier_post((unsigned*)(a.ws + WS_CTL) + 4096, MISC, wv);
#define SEAM() do { if (ph + 1 < hi) { xcd_barrier(bar, wv); if (PROBE_DUP == 11) xcd_barrier(bar, wv); } } while (0)
#else
#define SEAM() do { } while (0)
#endif
    const int lo = a.ph_lo, hi = a.ph_hi;
    int ph = 0;
#define IN_PHASE (ph >= lo && ph < hi)
#define NEXT_PHASE() do { if (IN_PHASE) SEAM(); ++ph; } while (0)

    if (IN_PHASE) { ph_prologue(wv); if (PROBE_DUP == 6) { __syncthreads(); ph_prologue(wv); } }
    NEXT_PHASE();
    for (int L = 0; L < 4; ++L) {
        if (L < 2) {
            if (IN_PHASE) { ph_qkv(wv, L); if (PROBE_DUP == 3) ph_qkv(wv, L); }
            NEXT_PHASE();
            if (IN_PHASE) { ph_attn_diff(wv, L); if (PROBE_DUP == 1) { __syncthreads(); ph_attn_diff(wv, L); } }
            NEXT_PHASE();
        } else {
            if (IN_PHASE) { ph_mla_a(wv, L - 2); if (PROBE_DUP == 3) ph_mla_a(wv, L - 2); }
            NEXT_PHASE();
            if (IN_PHASE) { ph_mla_qb(wv, L - 2); if (L == 2) ph_mla_kvb(wv); if (PROBE_DUP == 3) { ph_mla_qb(wv, L - 2); if (L == 2) ph_mla_kvb(wv); } }
            NEXT_PHASE();
            if (IN_PHASE) { ph_attn_mla(wv); if (PROBE_DUP == 2) { __syncthreads(); ph_attn_mla(wv); } }
            NEXT_PHASE();
        }
        if (IN_PHASE) { if (PROBE_DUP == 9) ph_wo(wv, L, true); ph_wo(wv, L, false); }  NEXT_PHASE();
        if (IN_PHASE) ph_ln_router(wv, L);  NEXT_PHASE();
        if (IN_PHASE) { ph_up(wv, L); if (PROBE_DUP == 4) { __syncthreads(); ph_up(wv, L); } }             NEXT_PHASE();
        if (IN_PHASE) { ph_down(wv, L); if (PROBE_DUP == 4) { __syncthreads(); ph_down(wv, L); } }           NEXT_PHASE();
        if (IN_PHASE) ph_ln_moe(wv, L);  NEXT_PHASE();
    }
}

extern "C" void kernel_launch(void* const* d_in, const int* in_sizes, int n_in, void* d_out, int out_size, void* d_ws, size_t ws_size, hipStream_t stream) {
    static int ok = 0;
    if (!ok) {
        if (n_in != 19 || out_size != T * D || ws_size < WS_END) { fprintf(stderr, "kernel_launch: unexpected shapes: n_in %d out %d ws %zu (need %zu)\n", n_in, out_size, ws_size, (size_t)WS_END); return; }
        if (hipFuncSetAttribute((const void*)mk_fwd, hipFuncAttributeMaxDynamicSharedMemorySize, LDS_BYTES) != hipSuccess) { fprintf(stderr, "kernel_launch: hipFuncSetAttribute failed\n"); return; }
        ok = 1;
    }
    Args a{};
    for (int i = 0; i < 19; ++i) a.in[i] = (const float*)d_in[i];
    a.out = (float*)d_out; a.ws = (unsigned char*)d_ws;
    if (hipMemsetAsync((char*)d_ws + WS_CTL, 0, CTL_ZERO_BYTES, stream) != hipSuccess) { fprintf(stderr, "kernel_launch: memset failed\n"); return; }
#if MK_SINGLE
    a.ph_lo = 0; a.ph_hi = NPH;
    hipLaunchKernelGGL(mk_fwd, dim3(GRID), dim3(NTHREADS), LDS_BYTES, stream, a);
#else
    for (int p = 0; p < NPH; ++p) { a.ph_lo = p; a.ph_hi = p + 1; hipLaunchKernelGGL(mk_fwd, dim3(GRID), dim3(NTHREADS), LDS_BYTES, stream, a); }
#endif
    const hipError_t le = hipPeekAtLastError();
    if (le != hipSuccess) fprintf(stderr, "kernel_launch: launch failed: %s\n", hipGetErrorName(le));
}
```
